# Optimizing an MI355X kernel written in HIP

```python
import jax, jax.numpy as jnp
from jax import lax
import numpy as np

D_MODEL = 1024
BATCH = 16
SEQ = 2048
DEPTH = 1
DEC_BATCH = 32
DEC_SEQ = 4
PAST_LEN = 16384
PAGE_SIZE = 128

D_CONV = D_MODEL // 2
D_ATTN = D_MODEL - D_CONV
HEAD_DIM = 64
N_HEADS = D_ATTN // HEAD_DIM
N_KV = 2
GQA_R = N_HEADS // N_KV
N_BR = 3
CONV_W = 3
BLK = 64
N_SEL = 16
WINDOW = 512
WIN_QB = 128
NW = WINDOW // WIN_QB
SEL_QC = 32
CMP_HID = HEAD_DIM
D_FF = ((8 * D_MODEL // 3) + 127) // 128 * 128
KV_W = 2 * N_KV * HEAD_DIM
D_IN = 3 * D_CONV + D_ATTN + 3 * KV_W + N_BR * N_HEADS
ALPHA = (2.0 * DEPTH) ** 0.25
BETA = (8.0 * DEPTH) ** -0.25
SCALE = HEAD_DIM ** -0.5
LN_EPS = 1e-5
NEG = -1e30
FORCE = 1e4

kernel_name = 'hybrid_shortconv_nsa_macaron_deepnorm_step'


def layer_norm(x, g, b):
    xf = x.astype(jnp.float32)
    mu = xf.mean(-1, keepdims=True)
    var = jnp.square(xf - mu).mean(-1, keepdims=True)
    return ((xf - mu) * lax.rsqrt(var + LN_EPS) * g + b).astype(x.dtype)


def post_ln(x, sub, g, b):
    return layer_norm(ALPHA * x + sub, g, b)


def swiglu(x, w_gate, w_up, w_down):
    return (jax.nn.silu(x @ w_gate) * (x @ w_up)) @ w_down


def masked_softmax(s, mask):
    s = jnp.where(mask, s.astype(jnp.float32), NEG)
    return jnp.where(mask, jax.nn.softmax(s, axis=-1), 0.0)


def project(h, w_in, b_in):
    n, t = h.shape[:2]
    z = h @ w_in + b_in
    sizes = [D_CONV, D_CONV, D_CONV, D_ATTN, KV_W, KV_W, KV_W]
    cuts = []
    acc = 0
    for s in sizes:
        acc += s
        cuts.append(acc)
    cb, cc, ch, q, kv_cmp, kv_sel, kv_win, g = jnp.split(z, cuts, axis=-1)
    kvshape = (n, t, 2, N_KV, HEAD_DIM)
    gates = jax.nn.sigmoid(g.astype(jnp.float32)).reshape(n, t, N_BR, N_HEADS).astype(h.dtype)
    return (cb, cc, ch, q.reshape(n, t, N_HEADS, HEAD_DIM), kv_cmp.reshape(kvshape),
            kv_sel.reshape(kvshape), kv_win.reshape(kvshape), gates)


def short_conv(u, prev, w_conv):
    t = u.shape[1]
    ext = jnp.concatenate([prev, u], axis=1)
    z = sum(ext[:, i:i + t] * w_conv[i] for i in range(CONV_W))
    return z, ext[:, -(CONV_W - 1):]


def compress(kv, w1, w2, pe):
    n, L = kv.shape[:2]
    nb = L // BLK
    blk = kv[:, :nb * BLK].reshape(n, nb, BLK, 2, N_KV, HEAD_DIM) + pe[:, :, None, :]
    hid = jax.nn.silu(jnp.einsum('nbpcgd,cpdh->nbcgh', blk, w1))
    return jnp.einsum('nbcgh,chd->nbcgd', hid, w2)


def cmp_attn(q, q_pos, kc):
    n, tq = q.shape[:2]
    nb = kc.shape[1]
    qg = q.reshape(n, tq, N_KV, GQA_R, HEAD_DIM)
    s = jnp.einsum('nqgrd,nbgd->ngrqb', qg, kc[:, :, 0]) * SCALE
    blk_end = (jnp.arange(nb) + 1) * BLK - 1
    p = masked_softmax(s, blk_end[None, :] <= q_pos[:, None])
    o = jnp.einsum('ngrqb,nbgd->nqgrd', p.astype(kc.dtype), kc[:, :, 1])
    return o.reshape(n, tq, N_HEADS, HEAD_DIM), p.sum(axis=2)


def select_blocks(imp, q_pos, n_blocks):
    n_cand = max(n_blocks, N_SEL)
    imp = jnp.pad(imp, ((0, 0), (0, 0), (0, 0), (0, n_cand - imp.shape[-1])))
    j = jnp.arange(n_cand)[None, :]
    cur = (q_pos // BLK)[:, None]
    score = jnp.where(j > cur, NEG, imp)
    score = jnp.where((j == 0) | (j == cur) | (j == cur - 1), FORCE, score)
    _, idx = lax.top_k(score, N_SEL)
    return idx


def to_blocks(kv):
    n, t = kv.shape[:2]
    nb = -(-t // BLK)
    kv = jnp.pad(kv, ((0, 0), (0, nb * BLK - t), (0, 0), (0, 0), (0, 0)))
    return kv.reshape(n, nb, BLK, 2, N_KV, HEAD_DIM)


def gather_blocks(new_blocks, idx, n_past_blk, pool_blocks=None, page_table=None):
    n = new_blocks.shape[0]
    nidx = jnp.arange(n)[:, None, None, None]
    gidx = jnp.arange(N_KV)[None, :, None, None]
    j_new = jnp.clip(idx - n_past_blk, 0, new_blocks.shape[1] - 1)
    out = new_blocks[nidx, j_new, :, :, gidx]
    if pool_blocks is not None:
        bpp = PAGE_SIZE // BLK
        jp = jnp.clip(idx, 0, n_past_blk - 1)
        page = jnp.take_along_axis(page_table, (jp // bpp).reshape(n, -1), axis=1).reshape(jp.shape)
        past = pool_blocks[page * bpp + jp % bpp, :, :, gidx]
        out = jnp.where((idx < n_past_blk)[..., None, None, None], past, out)
    return out


def sel_attn(q, q_pos, g, idx):
    n, tq = q.shape[:2]
    qg = q.reshape(n, tq, N_KV, GQA_R, HEAD_DIM)
    k = g[..., 0, :]
    v = g[..., 1, :]
    s = jnp.einsum('nqgrd,ngqspd->ngrqsp', qg, k) * SCALE
    kpos = idx[..., None] * BLK + jnp.arange(BLK)
    mask = (kpos <= q_pos[:, None, None])[:, :, None]
    p = masked_softmax(s.reshape(n, N_KV, GQA_R, tq, -1), mask.reshape(n, N_KV, 1, tq, -1))
    o = jnp.einsum('ngrqk,ngqkd->nqgrd', p.astype(v.dtype), v.reshape(n, N_KV, tq, -1, HEAD_DIM))
    return o.reshape(n, tq, N_HEADS, HEAD_DIM)


def win_attn(q, k, v, q_pos, k_pos):
    n, tq = q.shape[:2]
    qg = q.reshape(n, tq, N_KV, GQA_R, HEAD_DIM)
    s = jnp.einsum('nqgrd,nkgd->ngrqk', qg, k) * SCALE
    d = q_pos[:, None] - k_pos[None, :]
    p = masked_softmax(s, (d >= 0) & (d < WINDOW) & (k_pos[None, :] >= 0))
    o = jnp.einsum('ngrqk,nkgd->nqgrd', p.astype(v.dtype), v)
    return o.reshape(n, tq, N_HEADS, HEAD_DIM)


def win_prompt(q, kv):
    n, t = q.shape[:2]
    nqb = t // WIN_QB
    kvp = jnp.pad(kv, ((0, 0), (WINDOW, 0), (0, 0), (0, 0), (0, 0)))
    kvb = kvp.reshape(n, nqb + NW, WIN_QB, 2, N_KV, HEAD_DIM)
    band = jnp.concatenate([kvb[:, o:o + nqb] for o in range(NW + 1)], axis=2)
    kp = jnp.arange(-WINDOW, t).reshape(nqb + NW, WIN_QB)
    kp = jnp.concatenate([kp[o:o + nqb] for o in range(NW + 1)], axis=1)
    qp = jnp.arange(t).reshape(nqb, WIN_QB)

    def one(args):
        qb, kb, qpb, kpb = args
        return win_attn(qb, kb[:, :, 0], kb[:, :, 1], qpb, kpb)

    o = lax.map(one, (q.reshape(n, nqb, WIN_QB, N_HEADS, HEAD_DIM).swapaxes(0, 1),
                      band.swapaxes(0, 1), qp, kp))
    return o.swapaxes(0, 1).reshape(n, t, N_HEADS, HEAD_DIM)


def merge(gates, o_cmp, o_sel, o_win, y_conv, w_out):
    n, t = y_conv.shape[:2]
    o = (gates[:, :, 0, :, None] * o_cmp + gates[:, :, 1, :, None] * o_sel
         + gates[:, :, 2, :, None] * o_win)
    return jnp.concatenate([o.reshape(n, t, D_ATTN), y_conv], axis=-1) @ w_out


def mix_prompt(h, w_in, b_in, w_conv, cmp_w1, cmp_w2, cmp_pe, w_out):
    n, t = h.shape[:2]
    cb, cc, ch, q, kv_cmp, kv_sel, kv_win, gates = project(h, w_in, b_in)
    z, conv_state = short_conv(cc * ch, jnp.zeros((n, CONV_W - 1, D_CONV), h.dtype), w_conv)
    y_conv = cb * z
    q_pos = jnp.arange(t)
    o_cmp, imp = cmp_attn(q, q_pos, compress(kv_cmp, cmp_w1, cmp_w2, cmp_pe))
    idx = select_blocks(imp, q_pos, -(-t // BLK))
    blocks = to_blocks(kv_sel)
    nc = t // SEL_QC

    def sel_chunk(args):
        qc, pc, ic = args
        return sel_attn(qc, pc, gather_blocks(blocks, ic, 0), ic)

    o_sel = lax.map(sel_chunk, (q.reshape(n, nc, SEL_QC, N_HEADS, HEAD_DIM).swapaxes(0, 1),
                                q_pos.reshape(nc, SEL_QC),
                                idx.reshape(n, N_KV, nc, SEL_QC, N_SEL).transpose(2, 0, 1, 3, 4)))
    o_sel = o_sel.swapaxes(0, 1).reshape(n, t, N_HEADS, HEAD_DIM)
    o_win = win_prompt(q, kv_win)
    out = merge(gates, o_cmp, o_sel, o_win, y_conv, w_out)
    return out, kv_cmp, kv_sel, kv_win[:, -min(WINDOW, t):], conv_state


def mix_sample(h, cmp_pool, sel_pool, win_buf, conv_buf, page_table,
               w_in, b_in, w_conv, cmp_w1, cmp_w2, cmp_pe, w_out):
    n, s = h.shape[:2]
    past = page_table.shape[1] * PAGE_SIZE
    cb, cc, ch, q, kv_cmp, kv_sel, kv_win, gates = project(h, w_in, b_in)
    z, conv_state = short_conv(cc * ch, conv_buf, w_conv)
    y_conv = cb * z
    q_pos = past + jnp.arange(s)
    past_cmp = cmp_pool[page_table].reshape(n, past, 2, N_KV, HEAD_DIM)
    ctx_cmp = jnp.concatenate([past_cmp, kv_cmp], axis=1)
    o_cmp, imp = cmp_attn(q, q_pos, compress(ctx_cmp, cmp_w1, cmp_w2, cmp_pe))
    idx = select_blocks(imp, q_pos, -(-(past + s) // BLK))
    pool_blocks = sel_pool.reshape(-1, BLK, 2, N_KV, HEAD_DIM)
    g = gather_blocks(to_blocks(kv_sel), idx, past // BLK, pool_blocks, page_table)
    o_sel = sel_attn(q, q_pos, g, idx)
    ctx_win = jnp.concatenate([win_buf, kv_win], axis=1)
    k_pos = jnp.arange(past - win_buf.shape[1], past + s)
    o_win = win_attn(q, ctx_win[:, :, 0], ctx_win[:, :, 1], q_pos, k_pos)
    out = merge(gates, o_cmp, o_sel, o_win, y_conv, w_out)
    return out, kv_cmp, kv_sel, ctx_win[:, -min(WINDOW, past + s):], conv_state


def setup_inputs(seed: int = 0) -> dict:
    key = jax.random.key(seed)
    ks = iter(jax.random.split(key, 40))

    def nrm(shape, scale):
        return jax.random.normal(next(ks), shape, jnp.float32) * scale

    n_pages = PAST_LEN // PAGE_SIZE
    n_phys = (5 * DEC_BATCH * n_pages + 3) // 4
    win_rows = min(WINDOW, PAST_LEN)
    d = D_MODEL
    inp = {}
    inp['x_prompt'] = nrm((BATCH, SEQ, d), 1.0)
    inp['x_sample'] = nrm((DEC_BATCH, DEC_SEQ, d), 1.0)
    inp['cache_cmp_kv'] = nrm((DEPTH, n_phys, PAGE_SIZE, 2, N_KV, HEAD_DIM), 1.0)
    inp['cache_sel_kv'] = nrm((DEPTH, n_phys, PAGE_SIZE, 2, N_KV, HEAD_DIM), 1.0)
    inp['state_win_kv'] = nrm((DEPTH, DEC_BATCH, win_rows, 2, N_KV, HEAD_DIM), 1.0)
    inp['state_conv'] = nrm((DEPTH, DEC_BATCH, CONV_W - 1, D_CONV), 1.0)
    perm = jax.random.permutation(next(ks), n_phys)
    inp['page_table'] = perm[:DEC_BATCH * n_pages].reshape(DEC_BATCH, n_pages).astype(jnp.int32)
    inp['ffa_gate'] = nrm((DEPTH, d, D_FF), d ** -0.5)
    inp['ffa_up'] = nrm((DEPTH, d, D_FF), d ** -0.5)
    inp['ffa_down'] = nrm((DEPTH, D_FF, d), BETA * D_FF ** -0.5)
    inp['ln1_g'] = 1.0 + nrm((DEPTH, d), 0.02)
    inp['ln1_b'] = nrm((DEPTH, d), 0.02)
    inp['w_in'] = nrm((DEPTH, d, D_IN), d ** -0.5)
    inp['b_in'] = nrm((DEPTH, D_IN), 0.02)
    inp['w_conv'] = nrm((DEPTH, CONV_W, D_CONV), CONV_W ** -0.5)
    inp['cmp_w1'] = nrm((DEPTH, 2, BLK, HEAD_DIM, CMP_HID), (BLK * HEAD_DIM) ** -0.5)
    inp['cmp_w2'] = nrm((DEPTH, 2, CMP_HID, HEAD_DIM), CMP_HID ** -0.5)
    inp['cmp_pe'] = nrm((DEPTH, BLK, 2, HEAD_DIM), 0.1)
    inp['w_out'] = nrm((DEPTH, d, d), BETA * d ** -0.5)
    inp['ln2_g'] = 1.0 + nrm((DEPTH, d), 0.02)
    inp['ln2_b'] = nrm((DEPTH, d), 0.02)
    inp['ffb_gate'] = nrm((DEPTH, d, D_FF), d ** -0.5)
    inp['ffb_up'] = nrm((DEPTH, d, D_FF), d ** -0.5)
    inp['ffb_down'] = nrm((DEPTH, D_FF, d), BETA * D_FF ** -0.5)
    inp['ln3_g'] = 1.0 + nrm((DEPTH, d), 0.02)
    inp['ln3_b'] = nrm((DEPTH, d), 0.02)
    return inp


def reference(x_prompt, x_sample, cache_cmp_kv, cache_sel_kv, state_win_kv, state_conv, page_table,
              ffa_gate, ffa_up, ffa_down, ln1_g, ln1_b, w_in, b_in, w_conv, cmp_w1, cmp_w2, cmp_pe,
              w_out, ln2_g, ln2_b, ffb_gate, ffb_up, ffb_down, ln3_g, ln3_b):
    yp, ys = x_prompt, x_sample
    pc, psl, pw, pcv, sc, ssl, sw, scv = [], [], [], [], [], [], [], []
    for l in range(DEPTH):
        yp = post_ln(yp, 0.5 * swiglu(yp, ffa_gate[l], ffa_up[l], ffa_down[l]), ln1_g[l], ln1_b[l])
        ys = post_ln(ys, 0.5 * swiglu(ys, ffa_gate[l], ffa_up[l], ffa_down[l]), ln1_g[l], ln1_b[l])
        mp, a, b, c, e = mix_prompt(yp, w_in[l], b_in[l], w_conv[l], cmp_w1[l], cmp_w2[l], cmp_pe[l], w_out[l])
        pc.append(a); psl.append(b); pw.append(c); pcv.append(e)
        ms, a, b, c, e = mix_sample(ys, cache_cmp_kv[l], cache_sel_kv[l], state_win_kv[l], state_conv[l],
                                    page_table, w_in[l], b_in[l], w_conv[l], cmp_w1[l], cmp_w2[l],
                                    cmp_pe[l], w_out[l])
        sc.append(a); ssl.append(b); sw.append(c); scv.append(e)
        yp = post_ln(yp, mp, ln2_g[l], ln2_b[l])
        ys = post_ln(ys, ms, ln2_g[l], ln2_b[l])
        yp = post_ln(yp, 0.5 * swiglu(yp, ffb_gate[l], ffb_up[l], ffb_down[l]), ln3_g[l], ln3_b[l])
        ys = post_ln(ys, 0.5 * swiglu(ys, ffb_gate[l], ffb_up[l], ffb_down[l]), ln3_g[l], ln3_b[l])
    return (yp, ys, jnp.stack(pc), jnp.stack(psl), jnp.stack(pw), jnp.stack(pcv),
            jnp.stack(sc), jnp.stack(ssl), jnp.stack(sw), jnp.stack(scv))
```

```cpp
#include <hip/hip_runtime.h>
#include <cstdio>
#include <cstdint>
namespace pg8 {
#define PG8_LAS __attribute__((address_space(3)))
typedef unsigned short bf16_t;
typedef short bf16x8 __attribute__((ext_vector_type(8)));
typedef float f32x4 __attribute__((ext_vector_type(4)));
typedef unsigned u32x4 __attribute__((ext_vector_type(4)));
constexpr int BM = 256, BK = 64, HALF = 128, HTB = HALF * BK * 2  , STAGE_BYTES = 8 * HTB, NXCD = 8, WGM = 8;

__host__ __device__ __forceinline__ int lds_byte(int r, int c) { const int st = (r >> 4) * 2 + (c >> 5), rr = r & 15, cc = c & 31, ob = rr * 64 + cc * 2; return st * 1024 + (ob ^ (((ob >> 9) & 1) << 5)); }
__host__ __device__ __forceinline__ void stage_rc(int b, int& R, int& C) { const int st = b / 1024, sb = b % 1024, swz = sb ^ (((sb >> 9) & 1) << 5); R = (st >> 1) * 16 + swz / 64; C = (st & 1) * 32 + (swz % 64) / 2; }
__host__ __device__ __forceinline__ int perm32(int rho) { const int n = rho >> 4, i = rho & 15; return 8 * (i >> 2) + 4 * n + (i & 3); }

struct Unit { int pm, pn; };
struct Gemm { const bf16_t* A; const bf16_t* Bt; int M, N, K; };

struct StaticOrder {
    int nM, nN, nwg, G, c;
    __host__ __device__ void init(int M, int N, int G_, int c_) { nM = M / BM; nN = N / BM; nwg = nM * nN; G = G_; c = c_; }
    __host__ __device__ bool next(int i, Unit& u) const {
        const long L = (long)i * G + c; if (L >= nwg) return false;
        int wgid = (int)L; { const int q = nwg / NXCD, r = nwg % NXCD, xcd = wgid % NXCD, off = wgid / NXCD; wgid = (xcd < r ? xcd * (q + 1) : r * (q + 1) + (xcd - r) * q) + off; }
        const int nig = WGM * nN, gid = wgid / nig, fm = gid * WGM, gsz = (nM - fm) < WGM ? (nM - fm) : WGM;
        u.pm = fm + ((wgid % nig) % gsz); u.pn = (wgid % nig) / gsz; return true;
    }
    __device__ __forceinline__ void a_ready(const Unit&) const {}
    __device__ __forceinline__ void done(const Unit&) const {}
};

__device__ __forceinline__ unsigned cvt_pk_bf16(float lo, float hi) { unsigned r; asm volatile("v_cvt_pk_bf16_f32 %0, %1, %2" : "=v"(r) : "v"(lo), "v"(hi)); return r; }
typedef float f32x2 __attribute__((ext_vector_type(2)));
template <class Epi, class Sched, bool ALIGN_EPI = false, bool SP2 = false>
__device__ __forceinline__ void gemm_phase(PG8_LAS unsigned char* lds, const Gemm g, const Sched& S, const Epi& E) {
    const int tid = threadIdx.x, wid = __builtin_amdgcn_readfirstlane(tid >> 6), lane = tid & 63, wr = wid >> 2, wc = wid & 3, fr = lane & 15, fq = lane >> 4;
    const int K = g.K, nt = K / BK;
    unsigned voffA[2], voffB[2];
#pragma unroll
    for (int i = 0; i < 2; ++i) { int R, C; stage_rc(tid * 16 + i * 8192, R, C); const int Rb = Epi::PERM ? ((R & ~31) + perm32(R & 31)) : R;
        voffA[i] = (unsigned)(R * K + C) * 2u; voffB[i] = (unsigned)(Rb * K + C) * 2u; }
    const size_t kstep = (size_t)(BK * 2);
    const size_t hstep = (size_t)HALF * K * 2;
    const size_t tstep = 2 * hstep;
    const unsigned ldsw = (unsigned)wid * 1024u;
    const int aoff = lds_byte(wr * 64 + fr, fq * 8), boff = lds_byte(wc * 32 + fr, fq * 8);
#define PG8_SA(b, h) (((b) * 2 + (h)) * HTB)
#define PG8_SB(b, h) ((4 + (b) * 2 + (h)) * HTB)
#define PG8_STAGE(bufoff, gbase, voff) do { _Pragma("unroll") for (int _i = 0; _i < 2; ++_i) \
        __builtin_amdgcn_global_load_lds((const unsigned*)((const char*)(gbase) + (voff)[_i]), (PG8_LAS unsigned*)(lds + (bufoff) + ldsw + _i * 8192), 16, 0, 0); } while (0)
#define PG8_LDA(dst, b, h) do { _Pragma("unroll") for (int m = 0; m < 4; ++m) _Pragma("unroll") for (int k = 0; k < 2; ++k) dst[m][k] = *(const PG8_LAS bf16x8*)(lds + PG8_SA(b, h) + aoff + m * 2048 + k * 1024); } while (0)
#define PG8_LDB(dst, b, h) do { _Pragma("unroll") for (int n = 0; n < 2; ++n) _Pragma("unroll") for (int k = 0; k < 2; ++k) dst[n][k] = *(const PG8_LAS bf16x8*)(lds + PG8_SB(b, h) + boff + n * 2048 + k * 1024); } while (0)
#define PG8_MMA(ai, bj, At, Bt) do { __builtin_amdgcn_s_setprio(1); _Pragma("unroll") for (int m = 0; m < 4; ++m) _Pragma("unroll") for (int n = 0; n < 2; ++n) _Pragma("unroll") for (int k = 0; k < 2; ++k) \
        acc[ai][bj][m][n] = __builtin_amdgcn_mfma_f32_16x16x32_bf16(Bt[n][k], At[m][k], acc[ai][bj][m][n], 0, 0, 0); __builtin_amdgcn_s_setprio(0); } while (0)
#define PG8_WAIT_V(n) asm volatile("s_waitcnt vmcnt(" #n ")" ::: "memory")
#define PG8_WAIT_L(n) asm volatile("s_waitcnt lgkmcnt(" #n ")" ::: "memory")
#define PG8_BAR __builtin_amdgcn_s_barrier()
#define PG8_SCHED __builtin_amdgcn_sched_barrier(0)
    Unit cur, nxt; int ui = 0;
    if (!S.next(0, cur)) return;
    f32x4 acc[2][2][4][2];
#pragma unroll
    for (int a = 0; a < 2; ++a)
#pragma unroll
        for (int b = 0; b < 2; ++b)
#pragma unroll
            for (int m = 0; m < 4; ++m)
#pragma unroll
                for (int n = 0; n < 2; ++n) acc[a][b][m][n] = (f32x4){0.f, 0.f, 0.f, 0.f};
    bf16x8 At[4][2], B0[2][2], B1[2][2];
    const char* cA = (const char*)g.A + (size_t)cur.pm * tstep; const char* cB = (const char*)g.Bt + (size_t)cur.pn * tstep;
    S.a_ready(cur);
    if constexpr (SP2) {
        PG8_STAGE(PG8_SB(0, 0), cB, voffB); PG8_STAGE(PG8_SB(0, 1), cB + hstep, voffB); PG8_STAGE(PG8_SA(0, 0), cA, voffA); PG8_STAGE(PG8_SA(0, 1), cA + hstep, voffA);
        if (wr == 1) PG8_BAR;
        PG8_WAIT_V(2); PG8_BAR;
        PG8_STAGE(PG8_SB(1, 0), cB + kstep, voffB); PG8_STAGE(PG8_SA(1, 0), cA + kstep, voffA); PG8_STAGE(PG8_SB(1, 1), cB + hstep + kstep, voffB);
        PG8_WAIT_V(6); PG8_BAR;
    } else {
        PG8_STAGE(PG8_SB(0, 0), cB, voffB); PG8_STAGE(PG8_SA(0, 0), cA, voffA); PG8_STAGE(PG8_SB(0, 1), cB + hstep, voffB); PG8_STAGE(PG8_SA(0, 1), cA + hstep, voffA);
        if (wr == 1) PG8_BAR;
        PG8_WAIT_V(4); PG8_BAR;
        PG8_STAGE(PG8_SB(1, 0), cB + kstep, voffB); PG8_STAGE(PG8_SA(1, 0), cA + kstep, voffA); PG8_STAGE(PG8_SB(1, 1), cB + hstep + kstep, voffB);
        PG8_WAIT_V(6); PG8_BAR;
    }
    for (;;) {
        const bool has_next = S.next(ui + 1, nxt);
        const char* nA = has_next ? (const char*)g.A + (size_t)nxt.pm * tstep : cA; const char* nB = has_next ? (const char*)g.Bt + (size_t)nxt.pn * tstep : cB;
        for (int t = 0; t < nt; t += 2) {
            const bool last = (t == nt - 2);
            const char* a1 = cA + (size_t)(t + 1) * kstep;
            const char* a2 = last ? nA : cA + (size_t)(t + 2) * kstep; const char* b2 = last ? nB : cB + (size_t)(t + 2) * kstep;
            const char* a3 = a2 + kstep; const char* b3 = b2 + kstep;
            if (last && has_next) S.a_ready(nxt);
            if constexpr (SP2) {
            PG8_LDB(B0, 0, 0); PG8_LDB(B1, 0, 1); PG8_SCHED; PG8_LDA(At, 0, 0); PG8_STAGE(PG8_SA(1, 1), a1 + hstep, voffA);
            PG8_WAIT_V(8); PG8_WAIT_L(0); PG8_BAR; PG8_MMA(0, 0, At, B0); PG8_MMA(0, 1, At, B1); PG8_BAR; PG8_SCHED;
            PG8_LDA(At, 0, 1); PG8_STAGE(PG8_SB(0, 0), b2, voffB); PG8_STAGE(PG8_SB(0, 1), b2 + hstep, voffB); PG8_STAGE(PG8_SA(0, 0), a2, voffA);
            PG8_WAIT_V(8); PG8_WAIT_L(0); PG8_BAR; PG8_MMA(1, 0, At, B0); PG8_MMA(1, 1, At, B1); PG8_BAR; PG8_SCHED;
            PG8_LDB(B0, 1, 0); PG8_LDB(B1, 1, 1); PG8_SCHED; PG8_LDA(At, 1, 0); PG8_STAGE(PG8_SA(0, 1), a2 + hstep, voffA);
            PG8_WAIT_V(8); PG8_WAIT_L(0); PG8_BAR; PG8_MMA(0, 0, At, B0); PG8_MMA(0, 1, At, B1); PG8_BAR; PG8_SCHED;
            PG8_LDA(At, 1, 1); PG8_STAGE(PG8_SB(1, 0), b3, voffB); PG8_STAGE(PG8_SB(1, 1), b3 + hstep, voffB); PG8_STAGE(PG8_SA(1, 0), a3, voffA);
            PG8_WAIT_V(8); PG8_WAIT_L(0); PG8_BAR; PG8_MMA(1, 0, At, B0); PG8_MMA(1, 1, At, B1); PG8_BAR; PG8_SCHED;
            } else {
            PG8_LDB(B0, 0, 0); PG8_SCHED; PG8_LDA(At, 0, 0); PG8_STAGE(PG8_SA(1, 1), a1 + hstep, voffA);
            PG8_WAIT_L(8); PG8_BAR; PG8_WAIT_L(0); PG8_MMA(0, 0, At, B0); PG8_BAR; PG8_SCHED;
            PG8_LDB(B1, 0, 1); PG8_STAGE(PG8_SB(0, 0), b2, voffB);
            PG8_BAR; PG8_WAIT_L(0); PG8_MMA(0, 1, At, B1); PG8_BAR;
            PG8_LDA(At, 0, 1); PG8_STAGE(PG8_SA(0, 0), a2, voffA);
            PG8_BAR; PG8_WAIT_L(0); PG8_MMA(1, 0, At, B0); PG8_BAR; PG8_SCHED;
            PG8_STAGE(PG8_SB(0, 1), b2 + hstep, voffB);
            PG8_WAIT_V(6); PG8_BAR; PG8_MMA(1, 1, At, B1); PG8_BAR;
            PG8_LDB(B0, 1, 0); PG8_SCHED; PG8_LDA(At, 1, 0); PG8_STAGE(PG8_SA(0, 1), a2 + hstep, voffA);
            PG8_WAIT_L(8); PG8_BAR; PG8_WAIT_L(0); PG8_MMA(0, 0, At, B0); PG8_BAR; PG8_SCHED;
            PG8_LDB(B1, 1, 1); PG8_STAGE(PG8_SB(1, 0), b3, voffB);
            PG8_BAR; PG8_WAIT_L(0); PG8_MMA(0, 1, At, B1); PG8_BAR;
            PG8_LDA(At, 1, 1); PG8_STAGE(PG8_SA(1, 0), a3, voffA);
            PG8_BAR; PG8_WAIT_L(0); PG8_MMA(1, 0, At, B0); PG8_BAR; PG8_SCHED;
            PG8_STAGE(PG8_SB(1, 1), b3 + hstep, voffB);
            PG8_WAIT_V(6); PG8_BAR; PG8_MMA(1, 1, At, B1); PG8_BAR;
            }
        }
        if constexpr (ALIGN_EPI) { if (wr == 0) PG8_BAR; }
        if constexpr (!Epi::AFTER_DRAIN) { E(acc, cur, wr, wc, fr, fq); S.done(cur); }
        if (!has_next) break;
#pragma unroll
        for (int a = 0; a < 2; ++a)
#pragma unroll
            for (int b = 0; b < 2; ++b)
#pragma unroll
                for (int m = 0; m < 4; ++m)
#pragma unroll
                    for (int n = 0; n < 2; ++n) acc[a][b][m][n] = (f32x4){0.f, 0.f, 0.f, 0.f};
        cur = nxt; cA = nA; cB = nB; ++ui;
        if constexpr (ALIGN_EPI) { if (wr == 1) PG8_BAR; }
    }
    PG8_WAIT_V(0);
    if constexpr (!ALIGN_EPI) { if (wr == 0) PG8_BAR; }
    PG8_BAR;
    if constexpr (Epi::AFTER_DRAIN) { E.fused(acc, cur, wr, wc, fr, fq, lds, wid, lane); S.done(cur); }
#undef PG8_SA
#undef PG8_SB
#undef PG8_STAGE
#undef PG8_LDA
#undef PG8_LDB
#undef PG8_MMA
#undef PG8_WAIT_V
#undef PG8_WAIT_L
#undef PG8_BAR
#undef PG8_SCHED
}
}
constexpr int NWAVES = 8;
constexpr int D = 1024, FF = 2816, NGU = 2 * FF, NINP = 3072, DIN = 2840;
constexpr int NB = 16, T = 2048, MP = NB * T, SB = 32, SS = 4, MS = SB * SS, MR = MP + MS, M = 33024;
constexpr int DC = 512, DA = 512, HD = 64, NH = 8, NKV = 2, KVW = 256;
constexpr int PAST = 16384, PAGE = 128, NPAGES = PAST / PAGE, BLK = 64, NSEL = 16, WIN = 512;
constexpr int NBP = T / BLK  , NBS = PAST / BLK  ;
constexpr float ALPHA = 1.189207115002721f, LN_EPS = 1e-5f;
constexpr float QSCALE = 0.125f * 1.4426950408889634f;
constexpr size_t O_YP = 0, O_YS = (size_t)MP * D, O_PCMP = O_YS + (size_t)MS * D, O_PSEL = O_PCMP + (size_t)MP * KVW, O_PWIN = O_PSEL + (size_t)MP * KVW,
                 O_PCONV = O_PWIN + (size_t)NB * WIN * KVW, O_SCMP = O_PCONV + (size_t)NB * 2 * DC, O_SSEL = O_SCMP + (size_t)MS * KVW, O_SWIN = O_SSEL + (size_t)MS * KVW,
                 O_SCONV = O_SWIN + (size_t)SB * WIN * KVW, O_END = O_SCONV + (size_t)SB * 2 * DC;
static_assert(O_END == 56868864, "output size");
constexpr size_t MiB = 1u << 20;
constexpr size_t WS_CTL = 0, CTL_ZERO_BYTES = 1 * MiB;
constexpr size_t WS_WGUA = 2 * MiB, WS_WDA = 14 * MiB, WS_WIN = 20 * MiB, WS_WOUT = 26 * MiB, WS_WGUB = 28 * MiB, WS_WDB = 40 * MiB, WS_W1T = 46 * MiB, WS_BIASP = 47 * MiB;
constexpr size_t WS_KC = 48 * MiB;
constexpr size_t WS_XB = 64 * MiB;
constexpr size_t WS_H = 130 * MiB;
constexpr size_t WS_V = 308 * MiB;
constexpr size_t WS_X1 = 438 * MiB, WS_X2 = 568 * MiB;
constexpr size_t WS_CB = 698 * MiB;
constexpr size_t WS_U = 731 * MiB;
constexpr size_t WS_Q = 796 * MiB;
constexpr size_t WS_KS = 829 * MiB, WS_KW = 846 * MiB;
constexpr size_t WS_G = 863 * MiB;
constexpr size_t WS_A2 = 868 * MiB;
constexpr size_t WS_SELM = 933 * MiB;
constexpr size_t WS_END = 940 * MiB;
constexpr int CW_TMO = 0, CW_CODE = 1, CW_BAR = 4096;
constexpr int RING_OFF = 0, RING_BYTES = 131072;
constexpr int LDSCTL_OFF = RING_BYTES, MISC_OFF = LDSCTL_OFF + 320;
constexpr int LDS_BYTES = 147456;
namespace pg8 {
typedef unsigned u32x2 __attribute__((ext_vector_type(2)));
__device__ __forceinline__ float silu_mul(float g, float u) { return g * u * __builtin_amdgcn_rcpf(1.0f + __builtin_amdgcn_exp2f(-1.4426950408889634f * g)); }
struct EpiSwiGLU {
    static constexpr bool PERM = true, AFTER_DRAIN = false;
    bf16_t* H;
    __device__ __forceinline__ void operator()(const f32x4 (&acc)[2][2][4][2], const Unit& u, int wr, int wc, int fr, int fq) const {
        const int row0 = u.pm * BM + wr * 64 + fr, col0 = u.pn * HALF + wc * 32 + 8 * fq;
#pragma unroll
        for (int ai = 0; ai < 2; ++ai)
#pragma unroll
            for (int m = 0; m < 4; ++m) {
                const f32x4 g0 = acc[ai][0][m][0], g1 = acc[ai][0][m][1], u0 = acc[ai][1][m][0], u1 = acc[ai][1][m][1];
                u32x4 w;
                w.x = cvt_pk_bf16(silu_mul(g0[0], u0[0]), silu_mul(g0[1], u0[1])); w.y = cvt_pk_bf16(silu_mul(g0[2], u0[2]), silu_mul(g0[3], u0[3]));
                w.z = cvt_pk_bf16(silu_mul(g1[0], u1[0]), silu_mul(g1[1], u1[1])); w.w = cvt_pk_bf16(silu_mul(g1[2], u1[2]), silu_mul(g1[3], u1[3]));
                *(u32x4*)(H + (size_t)(row0 + ai * HALF + m * 16) * FF + col0) = w;
            }
    }
};
struct EpiResPre {
    static constexpr bool PERM = false, AFTER_DRAIN = false;
    const float* base_p; const float* base_s; float* V; float alpha, s;
    __device__ __forceinline__ void operator()(const f32x4 (&acc)[2][2][4][2], const Unit& u, int wr, int wc, int fr, int fq) const {
        const int col0 = u.pn * BM + wc * 32 + 4 * fq;
        const bool sp = (u.pm == MP / BM);
#pragma unroll
        for (int ai = 0; ai < 2; ++ai) {
            if (sp && ai == 1) continue;
#pragma unroll
            for (int m = 0; m < 4; ++m) {
                const int r = u.pm * BM + ai * HALF + wr * 64 + m * 16 + fr;
                const float* brow = sp ? base_s + (size_t)(r - MP) * D : base_p + (size_t)r * D;
                float* vrow = V + (size_t)r * D;
#pragma unroll
                for (int bj = 0; bj < 2; ++bj)
#pragma unroll
                    for (int n = 0; n < 2; ++n) { const int c = col0 + bj * HALF + n * 16; const f32x4 x = *(const f32x4*)(brow + c);
                        *(f32x4*)(vrow + c) = x * alpha + acc[ai][bj][m][n] * s; }
            }
        }
    }
};
struct EpiInProj {
    static constexpr bool PERM = false, AFTER_DRAIN = false;
    const float* biasp; bf16_t* CB; float* U; bf16_t* Q; bf16_t* KS; bf16_t* KW; float* G; float* out;
    __device__ __forceinline__ void operator()(const f32x4 (&acc)[2][2][4][2], const Unit& u, int wr, int wc, int fr, int fq) const {
        const int pn = u.pn; const bool sp = (u.pm == MP / BM);
        const int cl = wc * 32 + 4 * fq;
        f32x4 bv[2][2];
#pragma unroll
        for (int bj = 0; bj < 2; ++bj)
#pragma unroll
            for (int n = 0; n < 2; ++n) bv[bj][n] = *(const f32x4*)(biasp + pn * BM + bj * HALF + cl + n * 16);
#pragma unroll
        for (int ai = 0; ai < 2; ++ai) {
            if (sp && ai == 1) continue;
#pragma unroll
            for (int m = 0; m < 4; ++m) {
                const int r = u.pm * BM + ai * HALF + wr * 64 + m * 16 + fr;
                const int si = r - MP;
                const int tb = r & (T - 1), nb = r >> 11;
                if (pn < 2) {
#pragma unroll
                    for (int bj = 0; bj < 2; ++bj)
#pragma unroll
                        for (int n = 0; n < 2; ++n) { const f32x4 v = acc[ai][bj][m][n] + bv[bj][n]; u32x2 w; w.x = cvt_pk_bf16(v[0], v[1]); w.y = cvt_pk_bf16(v[2], v[3]);
                            *(u32x2*)(CB + (size_t)r * DC + pn * BM + bj * HALF + cl + n * 16) = w; }
                } else if (pn < 6) {
#pragma unroll
                    for (int n = 0; n < 2; ++n) { const f32x4 v = (acc[ai][0][m][n] + bv[0][n]) * (acc[ai][1][m][n] + bv[1][n]); const int ch = (pn - 2) * HALF + cl + n * 16;
                        *(f32x4*)(U + (size_t)r * DC + ch) = v;
                        if (!sp) { if (tb >= T - 2) *(f32x4*)(out + O_PCONV + (size_t)(nb * 2 + (tb - (T - 2))) * DC + ch) = v; }
                        else { const int s = si & 3; if (s >= 2) *(f32x4*)(out + O_SCONV + (size_t)((si >> 2) * 2 + (s - 2)) * DC + ch) = v; } }
                } else if (pn < 8) {
#pragma unroll
                    for (int bj = 0; bj < 2; ++bj)
#pragma unroll
                        for (int n = 0; n < 2; ++n) { const f32x4 v = (acc[ai][bj][m][n] + bv[bj][n]) * QSCALE; u32x2 w; w.x = cvt_pk_bf16(v[0], v[1]); w.y = cvt_pk_bf16(v[2], v[3]);
                            *(u32x2*)(Q + (size_t)r * DA + (pn - 6) * BM + bj * HALF + cl + n * 16) = w; }
                } else if (pn == 8) {
                    float* o = sp ? out + O_SCMP + (size_t)si * KVW : out + O_PCMP + (size_t)r * KVW;
#pragma unroll
                    for (int bj = 0; bj < 2; ++bj)
#pragma unroll
                        for (int n = 0; n < 2; ++n) *(f32x4*)(o + bj * HALF + cl + n * 16) = acc[ai][bj][m][n] + bv[bj][n];
                } else if (pn == 9) {
                    float* o = sp ? out + O_SSEL + (size_t)si * KVW : out + O_PSEL + (size_t)r * KVW;
#pragma unroll
                    for (int bj = 0; bj < 2; ++bj)
#pragma unroll
                        for (int n = 0; n < 2; ++n) { const f32x4 v = acc[ai][bj][m][n] + bv[bj][n]; *(f32x4*)(o + bj * HALF + cl + n * 16) = v;
                            u32x2 w; w.x = cvt_pk_bf16(v[0], v[1]); w.y = cvt_pk_bf16(v[2], v[3]); *(u32x2*)(KS + (size_t)r * KVW + bj * HALF + cl + n * 16) = w; }
                } else if (pn == 10) {
                    float* o = nullptr;
                    if (sp) o = out + O_SWIN + (size_t)((si >> 2) * WIN + (WIN - SS) + (si & 3)) * KVW;
                    else if (tb >= T - WIN) o = out + O_PWIN + (size_t)(nb * WIN + tb - (T - WIN)) * KVW;
#pragma unroll
                    for (int bj = 0; bj < 2; ++bj)
#pragma unroll
                        for (int n = 0; n < 2; ++n) { const f32x4 v = acc[ai][bj][m][n] + bv[bj][n]; if (o) *(f32x4*)(o + bj * HALF + cl + n * 16) = v;
                            u32x2 w; w.x = cvt_pk_bf16(v[0], v[1]); w.y = cvt_pk_bf16(v[2], v[3]); *(u32x2*)(KW + (size_t)r * KVW + bj * HALF + cl + n * 16) = w; }
                } else {
                    if (wc == 0) {
#pragma unroll
                        for (int n = 0; n < 2; ++n) { if (n == 1 && fq >= 2) continue; f32x4 v = acc[ai][0][m][n] + bv[0][n];
#pragma unroll
                            for (int j = 0; j < 4; ++j) v[j] = __builtin_amdgcn_rcpf(1.0f + __builtin_amdgcn_exp2f(-1.4426950408889634f * v[j]));
                            *(f32x4*)(G + (size_t)r * 32 + cl + n * 16) = v; }
                    }
                }
            }
        }
    }
};
}
#define GAS __attribute__((address_space(1)))
#define LAS __attribute__((address_space(3)))
typedef unsigned short bf16;
typedef unsigned v4u __attribute__((ext_vector_type(4)));
typedef float f32x4 __attribute__((ext_vector_type(4)));
typedef short bf16x8 __attribute__((ext_vector_type(8)));
typedef GAS unsigned gu32;
typedef GAS unsigned long long gu64;
#define RLX_AGENT __ATOMIC_RELAXED, __HIP_MEMORY_SCOPE_AGENT
#define LDS_WAIT() asm volatile("s_waitcnt lgkmcnt(0)" ::: "memory")
#define VM_WAIT() asm volatile("s_waitcnt vmcnt(0)" ::: "memory")
__device__ __forceinline__ unsigned long long rt() { return __builtin_amdgcn_s_memrealtime(); }
__device__ __forceinline__ unsigned f2bf(float f) { unsigned u = __builtin_bit_cast(unsigned, f); return (u + 0x7fffu + ((u >> 16) & 1u)) >> 16; }
__device__ __forceinline__ unsigned pk2(float lo, float hi) { return f2bf(lo) | (f2bf(hi) << 16); }
#define XB_TMO      128
#define XB_XCNT(j)  (256  + 64 * (j))
#define XB_XSUB(j)  (1280 + 64 * (j))
#define XB_XGEN(j)  (2304 + 64 * (j))
#define XB_TOP      3328
#define XB_TOPGEN   3392
#define XCD_BAR_WORDS 3456
#define XB_SPIN_CAP (1u << 18)

__device__ __forceinline__ unsigned xb_ld(unsigned* p)              { return __hip_atomic_load(p, __ATOMIC_RELAXED, __HIP_MEMORY_SCOPE_AGENT); }
__device__ __forceinline__ unsigned xb_add(unsigned* p, unsigned v) { return __hip_atomic_fetch_add(p, v, __ATOMIC_RELAXED, __HIP_MEMORY_SCOPE_AGENT); }
__device__ __forceinline__ unsigned xb_xcc_id() { return (unsigned)__builtin_amdgcn_s_getreg((3 << 11) | 20) & 0xFu; }
#define XB_SPIN(cond, bar) do { unsigned _sp = 0; while (cond) { __builtin_amdgcn_s_sleep(1); \
    if ((++_sp & 255u) == 0u) { if (xb_ld(&(bar)[XB_TMO])) break; if (_sp > XB_SPIN_CAP) { atomicAdd(&(bar)[XB_TMO], 1u); break; } } } } while (0)

struct XcdBarrier {
    unsigned* bar; unsigned x;
    volatile LAS unsigned* st;
};

__device__ __forceinline__ XcdBarrier xcd_barrier_post(unsigned* bar, volatile LAS unsigned* st) {
    XcdBarrier b; b.bar = bar; b.x = xb_xcc_id(); b.st = st;
    if (threadIdx.x == 0) (void)xb_add(&bar[XB_XCNT(b.x)], 1u);
    return b;
}
__device__ __forceinline__ void xcd_barrier_complete(unsigned* bar, unsigned x, unsigned& nloc, unsigned& nx) {
    const unsigned G = gridDim.x * gridDim.y * gridDim.z;
    unsigned sum, cnt, mine, sp = 0u;
    for (;;) {
        sum = 0u; cnt = 0u; mine = 0u;
#pragma unroll
        for (unsigned j = 0; j < 16; ++j) { const unsigned c = xb_ld(&bar[XB_XCNT(j)]); sum += c; cnt += (c > 0u) ? 1u : 0u; mine = (j == x) ? c : mine; }
        if (sum == G) break;
        __builtin_amdgcn_s_sleep(1);
        if ((++sp & 255u) == 0u) { if (xb_ld(&bar[XB_TMO])) break; if (sp > XB_SPIN_CAP) { atomicAdd(&bar[XB_TMO], 1u); break; } }
    }
    nloc = mine > 0u ? mine : 1u; nx = cnt > 0u ? cnt : 1u;
}

__device__ __forceinline__ void xcd_barrier(const XcdBarrier& b) {
    asm volatile("s_waitcnt vmcnt(0)" ::: "memory");
    __syncthreads();
    if (threadIdx.x == 0) {
        unsigned* bar = b.bar;
        __builtin_amdgcn_s_waitcnt(0);
        unsigned nloc = b.st[0], nx = b.st[1];
        if (nloc == 0u) { xcd_barrier_complete(bar, b.x, nloc, nx); b.st[0] = nloc; b.st[1] = nx; }
        const unsigned old = xb_add(&bar[XB_XSUB(b.x)], 1u);
        const unsigned gen = old / nloc;
        if (old + 1u == (gen + 1u) * nloc) {
            __builtin_amdgcn_fence(__ATOMIC_RELEASE, "agent");
            asm volatile("s_waitcnt vmcnt(0)" ::: "memory");
            const unsigned og = xb_add(&bar[XB_TOP], 1u);
            const unsigned tg = og / nx;
            if (og + 1u == (tg + 1u) * nx) xb_add(&bar[XB_TOPGEN], 1u);
            else XB_SPIN(xb_ld(&bar[XB_TOPGEN]) == tg, bar);
            __builtin_amdgcn_fence(__ATOMIC_ACQUIRE, "agent");
            xb_add(&bar[XB_XGEN(b.x)], 1u);
            asm volatile("s_waitcnt vmcnt(0)" ::: "memory");
        } else {
            XB_SPIN(xb_ld(&bar[XB_XGEN(b.x)]) == gen, bar);
            __builtin_amdgcn_fence(__ATOMIC_ACQUIRE, "agent");
            asm volatile("s_waitcnt vmcnt(0)" ::: "memory");
        }
    }
    __syncthreads();
}
struct Frame {
    LAS unsigned char* lds;
    volatile LAS unsigned* MISC;
    gu32* ctl;
    int tid, lane, wave;
    int vcu, G;
};
__device__ __forceinline__ float wave_sum(float v) {
#pragma unroll
    for (int o = 1; o < 64; o <<= 1) v += __shfl_xor(v, o);
    return v;
}
__device__ __forceinline__ float wave_max(float v) {
#pragma unroll
    for (int o = 1; o < 64; o <<= 1) v = fmaxf(v, __shfl_xor(v, o));
    return v;
}
__device__ __forceinline__ void p0_transpose_item(const float* W, int K, int N, bf16* WT, int dst_row0, int k0, int n0, int nvalid, LAS float* scr, int lane) {
#pragma unroll 8
    for (int i = 0; i < 32; ++i) { const int kk = 2 * i + (lane >> 5); const int n = lane & 31; scr[kk * 33 + n] = (n < nvalid) ? W[(size_t)(k0 + kk) * N + n0 + n] : 0.f; }
    LDS_WAIT(); asm volatile("" ::: "memory");
    const int c = lane & 7;
#pragma unroll
    for (int j = 0; j < 4; ++j) { const int n = (lane >> 3) + 8 * j; const LAS float* s = scr + (8 * c) * 33 + n;
        v4u o; o.x = pk2(s[0 * 33], s[1 * 33]); o.y = pk2(s[2 * 33], s[3 * 33]); o.z = pk2(s[4 * 33], s[5 * 33]); o.w = pk2(s[6 * 33], s[7 * 33]);
        *(GAS v4u*)(WT + (size_t)(dst_row0 + n) * K + k0 + 8 * c) = o; }
    LDS_WAIT(); asm volatile("" ::: "memory");
}
__device__ __forceinline__ int map_gu(int n0, int up) { return 256 * (n0 >> 7) + (n0 & 127) + (up ? 128 : 0); }
__device__ __forceinline__ int map_in(int n0) {
    if (n0 < 512) return n0;
    if (n0 < 1024) { const int ch = n0 - 512; return 512 + 256 * (ch >> 7) + (ch & 127); }
    if (n0 < 1536) { const int ch = n0 - 1024; return 512 + 256 * (ch >> 7) + 128 + (ch & 127); }
    return n0;
}
__device__ __forceinline__ int unmap_in(int r) {
    if (r < 512) return r;
    if (r < 1536) { const int t = (r - 512) >> 8, w = (r - 512) & 255; return w < 128 ? 512 + 128 * t + w : 1024 + 128 * t + (w - 128); }
    if (r < DIN) return r;
    return -1;
}
struct KArgs { const void* in[26]; float* out; unsigned char* ws; int ph_lo, ph_hi; };
__device__ __forceinline__ void p0_prologue(Frame& F, const KArgs& a) {
    LAS float* scr = (LAS float*)(F.lds + RING_OFF + F.wave * 16384);
    const int gw = F.vcu * NWAVES + F.wave, NGW = F.G * NWAVES;
    unsigned char* ws = a.ws;
    constexpr int I_GU = (D / 64) * (FF / 32), I_DN = (FF / 64) * (D / 32), I_IN = (D / 64) * ((DIN + 31) / 32), I_OUT = (D / 64) * (D / 32), I_W1 = (4096 / 64) * (64 / 32);
    constexpr int NITEMS = 4 * I_GU + 2 * I_DN + I_IN + I_OUT + 2 * I_W1;
    for (int it = gw; it < NITEMS; it += NGW) {
        int r = it;
        if (r < 4 * I_GU) { const int which = r / I_GU; r -= which * I_GU;
            const float* W = (const float*)a.in[which == 0 ? 7 : which == 1 ? 8 : which == 2 ? 21 : 22]; bf16* WT = (bf16*)(ws + (which < 2 ? WS_WGUA : WS_WGUB));
            const int nblk = FF / 32, kb = r / nblk, nb = r % nblk; p0_transpose_item(W, D, FF, WT, map_gu(32 * nb, which & 1), 64 * kb, 32 * nb, 32, scr, F.lane); continue; }
        r -= 4 * I_GU;
        if (r < 2 * I_DN) { const int which = r / I_DN; r -= which * I_DN;
            const float* W = (const float*)a.in[which == 0 ? 9 : 23]; bf16* WT = (bf16*)(ws + (which == 0 ? WS_WDA : WS_WDB));
            const int nblk = D / 32, kb = r / nblk, nb = r % nblk; p0_transpose_item(W, FF, D, WT, 32 * nb, 64 * kb, 32 * nb, 32, scr, F.lane); continue; }
        r -= 2 * I_DN;
        if (r < I_IN) { const int nblk = (DIN + 31) / 32, kb = r / nblk, nb = r % nblk; const int nv = (DIN - 32 * nb) < 32 ? (DIN - 32 * nb) : 32;
            p0_transpose_item((const float*)a.in[12], D, DIN, (bf16*)(ws + WS_WIN), map_in(32 * nb), 64 * kb, 32 * nb, nv, scr, F.lane); continue; }
        r -= I_IN;
        if (r < I_OUT) { const int nblk = D / 32, kb = r / nblk, nb = r % nblk; p0_transpose_item((const float*)a.in[18], D, D, (bf16*)(ws + WS_WOUT), 32 * nb, 64 * kb, 32 * nb, 32, scr, F.lane); continue; }
        r -= I_OUT;
        { const int c = r / I_W1; r -= c * I_W1; const int kb = r / 2, nb = r % 2;
          p0_transpose_item((const float*)a.in[15] + (size_t)c * 4096 * 64, 4096, 64, (bf16*)(ws + WS_W1T) + (size_t)c * 64 * 4096, 32 * nb, 64 * kb, 32 * nb, 32, scr, F.lane); }
    }
    { const int gt = F.vcu * (NWAVES * 64) + F.tid, NGT = F.G * NWAVES * 64;
      for (int i = gt; i < NINP; i += NGT) { const int s = unmap_in(i); ((float*)(ws + WS_BIASP))[i] = s >= 0 ? ((const float*)a.in[13])[s] : 0.f; }
      constexpr int ZR0 = ((DIN + 31) / 32) * 32; GAS v4u* z = (GAS v4u*)((bf16*)(ws + WS_WIN) + (size_t)ZR0 * D);
      for (int i = gt; i < (NINP - ZR0) * D / 8; i += NGT) z[i] = (v4u){0u, 0u, 0u, 0u};
      const GAS f32x4* sw = (const GAS f32x4*)a.in[4]; GAS f32x4* so = (GAS f32x4*)(a.out + O_SWIN);
      for (int i = gt; i < SB * (WIN - SS) * (KVW / 4); i += NGT) { const int n = i / ((WIN - SS) * (KVW / 4)), rem = i % ((WIN - SS) * (KVW / 4));
          so[(size_t)n * WIN * (KVW / 4) + rem] = sw[(size_t)n * WIN * (KVW / 4) + SS * (KVW / 4) + rem]; }
    }
    for (int m = gw; m < M; m += NGW) {
        GAS unsigned long long* o8 = (GAS unsigned long long*)((bf16*)(ws + WS_XB) + (size_t)m * D) + F.lane;
        if (m >= MR) {
#pragma unroll
            for (int j = 0; j < 4; ++j) o8[64 * j] = 0ull;
            continue; }
        const float* xrow = m < MP ? (const float*)a.in[0] + (size_t)m * D : (const float*)a.in[1] + (size_t)(m - MP) * D;
        const GAS f32x4* xr = (const GAS f32x4*)xrow + F.lane;
#pragma unroll
        for (int j = 0; j < 4; ++j) { const f32x4 v = xr[64 * j]; o8[64 * j] = (unsigned long long)pk2(v.x, v.y) | ((unsigned long long)pk2(v.z, v.w) << 32); }
    }
}
__device__ __forceinline__ void ln_phase(Frame& F, const float* V, const float* gam, const float* bet, float* of_p, float* of_s, bf16* XB) {
    const int gw = F.vcu * NWAVES + F.wave, NGW = F.G * NWAVES;
    f32x4 g4[4], b4[4];
#pragma unroll
    for (int j = 0; j < 4; ++j) { g4[j] = ((const GAS f32x4*)gam)[F.lane + 64 * j]; b4[j] = ((const GAS f32x4*)bet)[F.lane + 64 * j]; }
    for (int m = gw; m < M; m += NGW) {
        if (m >= MR) { if (XB) { GAS unsigned long long* o8 = (GAS unsigned long long*)(XB + (size_t)m * D) + F.lane;
#pragma unroll
                for (int j = 0; j < 4; ++j) o8[64 * j] = 0ull; }
            continue; }
        const GAS f32x4* xr = (const GAS f32x4*)(V + (size_t)m * D) + F.lane;
        f32x4 v[4]; float s = 0.f;
#pragma unroll
        for (int j = 0; j < 4; ++j) { v[j] = xr[64 * j]; s += (v[j].x + v[j].y) + (v[j].z + v[j].w); }
        const float mean = wave_sum(s) * (1.f / D); float s2 = 0.f;
#pragma unroll
        for (int j = 0; j < 4; ++j) { v[j] = v[j] - mean; s2 += (v[j].x * v[j].x + v[j].y * v[j].y) + (v[j].z * v[j].z + v[j].w * v[j].w); }
        const float rstd = 1.f / sqrtf(wave_sum(s2) * (1.f / D) + LN_EPS);
        float* orow = m < MP ? of_p + (size_t)m * D : of_s + (size_t)(m - MP) * D;
        GAS f32x4* of = (GAS f32x4*)orow + F.lane;
#pragma unroll
        for (int j = 0; j < 4; ++j) { v[j] = v[j] * rstd * g4[j] + b4[j]; of[64 * j] = v[j]; }
        if (XB) { GAS unsigned long long* o8 = (GAS unsigned long long*)(XB + (size_t)m * D) + F.lane;
#pragma unroll
            for (int j = 0; j < 4; ++j) o8[64 * j] = (unsigned long long)pk2(v[j].x, v[j].y) | ((unsigned long long)pk2(v[j].z, v[j].w) << 32); }
    }
}
__device__ __forceinline__ void conv_phase(Frame& F, const KArgs& a) {
    const int gw = F.vcu * NWAVES + F.wave, NGW = F.G * NWAVES;
    const float* U = (const float*)(a.ws + WS_U); const bf16* CB = (const bf16*)(a.ws + WS_CB); bf16* A2 = (bf16*)(a.ws + WS_A2);
    const float* wc = (const float*)a.in[14]; const float* sc = (const float*)a.in[5];
    f32x4 w0[2], w1[2], w2[2];
#pragma unroll
    for (int j = 0; j < 2; ++j) { const int ch = 4 * F.lane + 256 * j; w0[j] = *(const GAS f32x4*)(wc + ch); w1[j] = *(const GAS f32x4*)(wc + DC + ch); w2[j] = *(const GAS f32x4*)(wc + 2 * DC + ch); }
    for (int m = gw; m < MR; m += NGW) {
#pragma unroll
        for (int j = 0; j < 2; ++j) {
            const int ch = 4 * F.lane + 256 * j;
            const f32x4 uc = *(const GAS f32x4*)(U + (size_t)m * DC + ch);
            f32x4 u1, u2;
            if (m < MP) { const int t = m & (T - 1);
                u1 = t >= 1 ? *(const GAS f32x4*)(U + (size_t)(m - 1) * DC + ch) : (f32x4){0.f, 0.f, 0.f, 0.f};
                u2 = t >= 2 ? *(const GAS f32x4*)(U + (size_t)(m - 2) * DC + ch) : (f32x4){0.f, 0.f, 0.f, 0.f};
            } else { const int si = m - MP, n = si >> 2, s = si & 3;
                u1 = s >= 1 ? *(const GAS f32x4*)(U + (size_t)(m - 1) * DC + ch) : *(const GAS f32x4*)(sc + (size_t)(n * 2 + 1) * DC + ch);
                u2 = s >= 2 ? *(const GAS f32x4*)(U + (size_t)(m - 2) * DC + ch) : *(const GAS f32x4*)(sc + (size_t)(n * 2 + s) * DC + ch);
            }
            const unsigned long long cbw = *(const GAS unsigned long long*)(CB + (size_t)m * DC + ch);
            f32x4 cb; cb.x = __uint_as_float((unsigned)(cbw & 0xffffu) << 16); cb.y = __uint_as_float((unsigned)((cbw >> 16) & 0xffffu) << 16);
            cb.z = __uint_as_float((unsigned)((cbw >> 32) & 0xffffu) << 16); cb.w = __uint_as_float((unsigned)((cbw >> 48) & 0xffffu) << 16);
            const f32x4 y = cb * (w0[j] * u2 + w1[j] * u1 + w2[j] * uc);
            *(GAS unsigned long long*)(A2 + (size_t)m * D + DA + ch) = (unsigned long long)pk2(y.x, y.y) | ((unsigned long long)pk2(y.z, y.w) << 32);
        }
    }
}
constexpr int CMP_NBLKS = NB * NBP + SB * NBS, CMP_UB = 34, CMP_UNITS = CMP_NBLKS / CMP_UB;
static_assert(CMP_UNITS * CMP_UB == CMP_NBLKS, "compress units");
constexpr int CL_PTR = 0, CL_A = 1024, CL_ABYTES = CMP_UB * 512, CL_HID = 36864;
static_assert(CL_A + 2 * CL_ABYTES <= CL_HID, "compress LDS map");
__device__ __forceinline__ void compress_phase(Frame& F, const KArgs& a) {
    typedef short bf16x8v __attribute__((ext_vector_type(8)));
    const int tid = F.tid, lane = F.lane, wid = F.wave;
    const float* pe = (const float*)a.in[17]; const float* w2 = (const float*)a.in[16];
    const bf16* W1T = (const bf16*)(a.ws + WS_W1T); float* KC = (float*)(a.ws + WS_KC);
    const int* pt = (const int*)a.in[6]; const float* pool = (const float*)a.in[2];
    LAS unsigned long long* ptrs = (LAS unsigned long long*)(F.lds + CL_PTR);
    LAS float* hid = (LAS float*)(F.lds + CL_HID);
    const int c_w = wid >> 2, hq = wid & 3;
    for (int unit = F.vcu; unit < CMP_UNITS; unit += F.G) {
        const int blk0 = unit * CMP_UB;
        __syncthreads();
        if (tid < CMP_UB) { const int id = blk0 + tid; const float* src;
            if (id < NB * NBP) { const int n = id >> 5, b = id & 31; src = a.out + O_PCMP + (size_t)(n * T + b * BLK) * KVW; }
            else { const int sid = id - NB * NBP, n = sid >> 8, b = sid & 255; const int page = pt[n * NPAGES + (b >> 1)]; src = pool + ((size_t)page * PAGE + (size_t)(b & 1) * BLK) * KVW; }
            ptrs[tid] = (unsigned long long)(uintptr_t)src; }
        __syncthreads();
        const float* sp[5]; int e4[5]; bool ok[5];
#pragma unroll
        for (int k = 0; k < 5; ++k) { const int f = tid + 512 * k; ok[k] = f < CMP_UB * 64; const int b = ok[k] ? (f >> 6) : 0; e4[k] = f & 63; sp[k] = (const float*)(uintptr_t)ptrs[b] + e4[k] * 4; }
        f32x4 st[5]; bf16x8v bw[2];
#pragma unroll
        for (int k = 0; k < 5; ++k) if (ok[k]) st[k] = *(const GAS f32x4*)(sp[k]);
        const bf16* wrow = W1T + ((size_t)c_w * 64 + hq * 16 + (lane & 15)) * 4096 + 8 * (lane >> 4);
        bw[0] = *(const GAS bf16x8v*)(wrow); bw[1] = *(const GAS bf16x8v*)(wrow + 32);
        f32x4 acc[5];
#pragma unroll
        for (int mt = 0; mt < 5; ++mt) acc[mt] = (f32x4){0.f, 0.f, 0.f, 0.f};
        for (int p = 0; p < BLK; ++p) {
            LAS unsigned char* abuf = F.lds + CL_A + (p & 1) * CL_ABYTES;
#pragma unroll
            for (int k = 0; k < 5; ++k) if (ok[k]) { const int f = tid + 512 * k; const f32x4 pv = *(const GAS f32x4*)(pe + p * 128 + (e4[k] >> 5) * 64 + (e4[k] & 15) * 4); const f32x4 v = st[k] + pv;
                *(LAS unsigned long long*)(abuf + (f >> 6) * 512 + e4[k] * 8) = (unsigned long long)pk2(v.x, v.y) | ((unsigned long long)pk2(v.z, v.w) << 32); }
            const bf16x8v b0 = bw[0], b1 = bw[1];
            if (p + 1 < BLK) {
#pragma unroll
                for (int k = 0; k < 5; ++k) if (ok[k]) st[k] = *(const GAS f32x4*)(sp[k] + (size_t)(p + 1) * KVW);
                bw[0] = *(const GAS bf16x8v*)(wrow + (p + 1) * 64); bw[1] = *(const GAS bf16x8v*)(wrow + (p + 1) * 64 + 32);
            }
            __syncthreads();
#pragma unroll
            for (int mt = 0; mt < 5; ++mt) { int row = mt * 16 + (lane & 15); if (row >= 2 * CMP_UB) row = 2 * CMP_UB - 1;
                const LAS unsigned char* ap = abuf + (row >> 1) * 512 + (c_w * 128 + (row & 1) * 64 + 8 * (lane >> 4)) * 2;
                const bf16x8v a0 = *(const LAS bf16x8v*)(ap), a1 = *(const LAS bf16x8v*)(ap + 64);
                acc[mt] = __builtin_amdgcn_mfma_f32_16x16x32_bf16(a0, b0, acc[mt], 0, 0, 0);
                acc[mt] = __builtin_amdgcn_mfma_f32_16x16x32_bf16(a1, b1, acc[mt], 0, 0, 0); }
        }
#pragma unroll
        for (int mt = 0; mt < 5; ++mt)
#pragma unroll
            for (int i = 0; i < 4; ++i) { const int row = mt * 16 + (lane >> 4) * 4 + i; const float x = acc[mt][i];
                hid[(c_w * 80 + row) * 64 + hq * 16 + (lane & 15)] = x * __builtin_amdgcn_rcpf(1.0f + __builtin_amdgcn_exp2f(-1.4426950408889634f * x)); }
        __syncthreads();
        for (int pr = wid; pr < 2 * 2 * CMP_UB; pr += NWAVES) { const int c = pr / (2 * CMP_UB), row = pr % (2 * CMP_UB);
            const LAS float* hr = hid + (c * 80 + row) * 64; const float* wp = w2 + (size_t)c * 64 * 64 + lane; float s = 0.f;
#pragma unroll 16
            for (int h = 0; h < 64; ++h) s += hr[h] * wp[h * 64];
            KC[(size_t)(blk0 + (row >> 1)) * 256 + c * 128 + (row & 1) * 64 + lane] = s; }
    }
}
__device__ __forceinline__ float bf2f(unsigned short x) { return __uint_as_float((unsigned)x << 16); }
__device__ __forceinline__ int wave_min_i(int v) {
#pragma unroll
    for (int o = 1; o < 64; o <<= 1) { const int t = __shfl_xor(v, o); v = t < v ? t : v; }
    return v;
}
template <bool F32> __device__ __forceinline__ void dot4h(const void* krow, const LAS float* qf, float (&s)[4]) {
    s[0] = s[1] = s[2] = s[3] = 0.f;
    if (F32) {
#pragma unroll
        for (int d4 = 0; d4 < 16; ++d4) { const f32x4 k = ((const GAS f32x4*)krow)[d4];
#pragma unroll
            for (int h = 0; h < 4; ++h) { const f32x4 q = ((const LAS f32x4*)qf)[h * 16 + d4]; s[h] += (k.x * q.x + k.y * q.y) + (k.z * q.z + k.w * q.w); } }
    } else {
#pragma unroll
        for (int d8 = 0; d8 < 8; ++d8) { const v4u kk = ((const GAS v4u*)krow)[d8];
            const f32x4 k0 = {__uint_as_float(kk.x << 16), __uint_as_float(kk.x & 0xffff0000u), __uint_as_float(kk.y << 16), __uint_as_float(kk.y & 0xffff0000u)};
            const f32x4 k1 = {__uint_as_float(kk.z << 16), __uint_as_float(kk.z & 0xffff0000u), __uint_as_float(kk.w << 16), __uint_as_float(kk.w & 0xffff0000u)};
#pragma unroll
            for (int h = 0; h < 4; ++h) { const f32x4 q0 = ((const LAS f32x4*)qf)[h * 16 + 2 * d8], q1 = ((const LAS f32x4*)qf)[h * 16 + 2 * d8 + 1];
                s[h] += ((k0.x * q0.x + k0.y * q0.y) + (k0.z * q0.z + k0.w * q0.w)) + ((k1.x * q1.x + k1.y * q1.y) + (k1.z * q1.z + k1.w * q1.w)); } }
    }
}
__device__ __forceinline__ void osm_update(const float (&s)[4], bool valid, float (&m)[4], float (&l)[4], float (&o)[4], LAS float* pb, int lane) {
#pragma unroll
    for (int h = 0; h < 4; ++h) {
        const float mb = wave_max(valid ? s[h] : -INFINITY);
        const float mn = fmaxf(m[h], mb);
        const float al = (m[h] == -INFINITY) ? 0.f : __builtin_amdgcn_exp2f(m[h] - mn);
        const float p = valid ? __builtin_amdgcn_exp2f(s[h] - mn) : 0.f;
        l[h] = l[h] * al + wave_sum(p); o[h] *= al; m[h] = mn; pb[h * 64 + lane] = p;
    }
}
template <bool SAMPLE> __device__ __forceinline__ void attn_task(Frame& F, const KArgs& a, int n, int g, int tq) {
    const int lane = F.lane;
    LAS float* wl = (LAS float*)(F.lds + F.wave * 16384);
    LAS float* qf = wl; LAS float* pb = wl + 256; LAS int* sl = (LAS int*)(wl + 256 + 1024);
    const int row = SAMPLE ? MP + n * SS + tq : n * T + tq;
    const int qpos = SAMPLE ? PAST + tq : tq;
    const unsigned char* ws = a.ws;
    const bf16* Q = (const bf16*)(ws + WS_Q); const bf16* KS = (const bf16*)(ws + WS_KS); const bf16* KW = (const bf16*)(ws + WS_KW);
    LDS_WAIT(); asm volatile("" ::: "memory");
#pragma unroll
    for (int h = 0; h < 4; ++h) qf[h * 64 + lane] = bf2f(Q[(size_t)row * DA + (g * 4 + h) * 64 + lane]);
    LDS_WAIT(); asm volatile("" ::: "memory");
    constexpr int NBLK = SAMPLE ? NBS : NBP, NC = SAMPLE ? 4 : 1;
    const float* KC = (const float*)(ws + WS_KC) + (size_t)(SAMPLE ? (NB * NBP + n * NBS) : n * NBP) * 256;
    float imp[NC]; float ocmp[4] = {0.f, 0.f, 0.f, 0.f};
    {
#pragma unroll 1
        for (int jj = 0; jj < NC; ++jj) { const int j = lane + 64 * jj; const bool vis = (j < NBLK) && ((j + 1) * BLK - 1 <= qpos);
            if (j < NBLK) { float s4[4]; dot4h<true>(KC + (size_t)j * 256 + g * 64, qf, s4);
#pragma unroll
                for (int h = 0; h < 4; ++h) pb[h * 256 + j] = vis ? s4[h] : -INFINITY; } }
        LDS_WAIT(); asm volatile("" ::: "memory");
#pragma unroll
        for (int jj = 0; jj < NC; ++jj) imp[jj] = 0.f;
#pragma unroll
        for (int h = 0; h < 4; ++h) {
            float sv[NC]; float mx = -INFINITY;
#pragma unroll
            for (int jj = 0; jj < NC; ++jj) { sv[jj] = (lane + 64 * jj < NBLK) ? pb[h * 256 + lane + 64 * jj] : -INFINITY; mx = fmaxf(mx, sv[jj]); }
            mx = wave_max(mx);
            float e[NC], sum = 0.f;
#pragma unroll
            for (int jj = 0; jj < NC; ++jj) { e[jj] = (sv[jj] > -INFINITY) ? __builtin_amdgcn_exp2f(sv[jj] - mx) : 0.f; sum += e[jj]; }
            sum = wave_sum(sum); const float inv = sum > 0.f ? 1.0f / sum : 0.f;
#pragma unroll
            for (int jj = 0; jj < NC; ++jj) { const float p = e[jj] * inv; imp[jj] += p; if (lane + 64 * jj < NBLK) pb[h * 256 + lane + 64 * jj] = p; }
        }
        LDS_WAIT(); asm volatile("" ::: "memory");
        int nvis = (qpos + 1) / BLK; if (nvis > NBLK) nvis = NBLK;
        for (int j = 0; j < nvis; ++j) { const float v = KC[(size_t)j * 256 + 128 + g * 64 + lane];
#pragma unroll
            for (int h = 0; h < 4; ++h) ocmp[h] += pb[h * 256 + j] * v; }
        LDS_WAIT(); asm volatile("" ::: "memory");
    }
    const int cur = qpos >> 6;
    {
        float cand[NC];
#pragma unroll
        for (int jj = 0; jj < NC; ++jj) { const int j = lane + 64 * jj;
            cand[jj] = (j >= NBLK) ? -INFINITY : (j > cur) ? -1e30f : (j == 0 || j == cur || j == cur - 1) ? 1e4f : imp[jj]; }
        constexpr int NIT = SAMPLE ? NSEL - 1 : NSEL;
        for (int it = 0; it < NIT; ++it) {
            float lm = cand[0];
#pragma unroll
            for (int jj = 1; jj < NC; ++jj) lm = fmaxf(lm, cand[jj]);
            const float mx = wave_max(lm);
            int lj = 0x7fffffff;
#pragma unroll
            for (int jj = NC - 1; jj >= 0; --jj) if (cand[jj] == mx) lj = lane + 64 * jj;
            const int sj = wave_min_i(lj);
            if (lane == 0) sl[it] = sj;
#pragma unroll
            for (int jj = 0; jj < NC; ++jj) if (lane + 64 * jj == sj) cand[jj] = -INFINITY;
        }
        if (SAMPLE) { if (lane == 0) sl[NSEL - 1] = NBS; }
        LDS_WAIT(); asm volatile("" ::: "memory");
    }
    float osel[4] = {0.f, 0.f, 0.f, 0.f};
    {
        float m[4] = {-INFINITY, -INFINITY, -INFINITY, -INFINITY}, l[4] = {0.f, 0.f, 0.f, 0.f};
        for (int i = 0; i < NSEL; ++i) {
            const int j = __builtin_amdgcn_readfirstlane(sl[i]);
            if (j > cur) continue;
            const int kpos = j * BLK + lane; const bool valid = kpos <= qpos;
            float s[4];
            if (!SAMPLE) {
                const bf16* kb = KS + (size_t)(n * T + j * BLK) * KVW + g * 64;
                dot4h<false>(kb + (size_t)lane * KVW, qf, s);
                osm_update(s, valid, m, l, osel, pb, lane);
                LDS_WAIT(); asm volatile("" ::: "memory");
                for (int k = 0; k < BLK; ++k) { const float v = bf2f(kb[(size_t)k * KVW + 128 + lane]);
#pragma unroll
                    for (int h = 0; h < 4; ++h) osel[h] += pb[h * 64 + k] * v; }
            } else {
                const float* kb; int nk = BLK;
                if (j < NBS) { const int page = ((const int*)a.in[6])[n * NPAGES + (j >> 1)]; kb = (const float*)a.in[3] + ((size_t)page * PAGE + (size_t)(j & 1) * BLK) * KVW + g * 64; }
                else { kb = a.out + O_SSEL + (size_t)(n * SS) * KVW + g * 64; nk = SS; }
                const int kl = lane < nk ? lane : nk - 1;
                dot4h<true>(kb + (size_t)kl * KVW, qf, s);
                osm_update(s, valid && lane < nk, m, l, osel, pb, lane);
                LDS_WAIT(); asm volatile("" ::: "memory");
                for (int k = 0; k < nk; ++k) { const float v = kb[(size_t)k * KVW + 128 + lane];
#pragma unroll
                    for (int h = 0; h < 4; ++h) osel[h] += pb[h * 64 + k] * v; }
            }
            LDS_WAIT(); asm volatile("" ::: "memory");
        }
#pragma unroll
        for (int h = 0; h < 4; ++h) osel[h] = l[h] > 0.f ? osel[h] / l[h] : 0.f;
    }
    float owin[4] = {0.f, 0.f, 0.f, 0.f};
    {
        float m[4] = {-INFINITY, -INFINITY, -INFINITY, -INFINITY}, l[4] = {0.f, 0.f, 0.f, 0.f};
        for (int c = 0; c < WIN / 64; ++c) {
            float s[4];
            if (!SAMPLE) {
                const int k0 = qpos - (WIN - 1) + 64 * c; if (k0 + 63 < 0) continue;
                const int kpos = k0 + lane; const bool valid = kpos >= 0; const int kc = valid ? kpos : 0;
                dot4h<false>(KW + (size_t)(n * T + kc) * KVW + g * 64, qf, s);
                osm_update(s, valid, m, l, owin, pb, lane);
                LDS_WAIT(); asm volatile("" ::: "memory");
                for (int k = 0; k < 64; ++k) { const int kp = k0 + k; if (kp < 0) continue; const float v = bf2f(KW[(size_t)(n * T + kp) * KVW + 128 + g * 64 + lane]);
#pragma unroll
                    for (int h = 0; h < 4; ++h) owin[h] += pb[h * 64 + k] * v; }
            } else {
                const int i0 = tq + 1 + 64 * c;
                const float* st = (const float*)a.in[4] + (size_t)n * WIN * KVW; const float* nw = a.out + O_SWIN + (size_t)(n * WIN + (WIN - SS)) * KVW;
                const int i = i0 + lane; const float* kr = (i < WIN ? st + (size_t)i * KVW : nw + (size_t)(i - WIN) * KVW) + g * 64;
                dot4h<true>(kr, qf, s);
                osm_update(s, true, m, l, owin, pb, lane);
                LDS_WAIT(); asm volatile("" ::: "memory");
                for (int k = 0; k < 64; ++k) { const int ik = i0 + k; const float v = (ik < WIN ? st + (size_t)ik * KVW : nw + (size_t)(ik - WIN) * KVW)[128 + g * 64 + lane];
#pragma unroll
                    for (int h = 0; h < 4; ++h) owin[h] += pb[h * 64 + k] * v; }
            }
            LDS_WAIT(); asm volatile("" ::: "memory");
        }
#pragma unroll
        for (int h = 0; h < 4; ++h) owin[h] = l[h] > 0.f ? owin[h] / l[h] : 0.f;
    }
    const float* G = (const float*)(ws + WS_G) + (size_t)row * 32; bf16* A2 = (bf16*)(ws + WS_A2);
#pragma unroll
    for (int h = 0; h < 4; ++h) { const int hh = g * 4 + h; const float o = G[hh] * ocmp[h] + G[8 + hh] * osel[h] + G[16 + hh] * owin[h];
        A2[(size_t)row * D + hh * 64 + lane] = (bf16)f2bf(o); }
}
__device__ __forceinline__ void attn_phase(Frame& F, const KArgs& a) {
    { const int gt = F.vcu * (NWAVES * 64) + F.tid, NGT = F.G * NWAVES * 64; bf16* A2 = (bf16*)(a.ws + WS_A2);
      for (int i = gt; i < (M - MR) * (D / 8); i += NGT) *(GAS v4u*)(A2 + (size_t)MR * D + (size_t)i * 8) = (v4u){0u, 0u, 0u, 0u}; }
#ifndef NO_SAMPLE
    for (int task = F.vcu + F.G * F.wave; task < SB * NKV * SS; task += F.G * NWAVES) { const int n = task >> 3, g = (task >> 2) & 1, s = task & 3; attn_task<true>(F, a, n, g, s); }
#endif
#ifndef NO_PROMPT
    const int per = (NB * NKV * T + F.G - 1) / F.G;
    for (int i = F.wave; i < per; i += NWAVES) { const int task = F.vcu * per + i; if (task >= NB * NKV * T) break;
        const int n = task >> 12, g = (task >> 11) & 1, t = task & (T - 1); attn_task<false>(F, a, n, g, t); }
#endif
}
#ifndef ATTN_PLACEHOLDER
#define ATTN_PLACEHOLDER 0
#endif
__global__ void __launch_bounds__(NWAVES * 64, 2) mk_fwd(KArgs args) {
    extern __shared__ __attribute__((aligned(16))) unsigned char lds[];
    Frame F;
    F.lds = (LAS unsigned char*)lds;
    F.MISC = (volatile LAS unsigned*)(F.lds + MISC_OFF);
    F.tid = threadIdx.x; F.lane = F.tid & 63; F.wave = __builtin_amdgcn_readfirstlane(F.tid >> 6);
    F.G = gridDim.x; { const int bx = blockIdx.x; F.vcu = (F.G % 8 == 0) ? (bx % 8) * (F.G / 8) + bx / 8 : bx; }
    unsigned char* ws = args.ws;
    F.ctl = (gu32*)(ws + WS_CTL);
    for (int u = F.tid; u < (LDS_BYTES - LDSCTL_OFF) / 4; u += NWAVES * 64) ((LAS unsigned*)(F.lds + LDSCTL_OFF))[u] = 0u;
    __syncthreads();
    XcdBarrier bar = xcd_barrier_post((unsigned*)(F.ctl + CW_BAR), F.MISC + 8);
    const int lo = args.ph_lo, hi = args.ph_hi;
#define IN(k) (lo <= (k) && (k) < hi)
#define GRID_BAR() xcd_barrier(bar)
    bf16* XB = (bf16*)(ws + WS_XB); bf16* HB = (bf16*)(ws + WS_H); float* V = (float*)(ws + WS_V); float* X1 = (float*)(ws + WS_X1); float* X2 = (float*)(ws + WS_X2);
    bf16* A2 = (bf16*)(ws + WS_A2);
    float* out = args.out;

    if (IN(0)) { p0_prologue(F, args); GRID_BAR(); }
    if (IN(1)) { pg8::Gemm g{XB, (const bf16*)(ws + WS_WGUA), M, NGU, D}; pg8::StaticOrder S; S.init(M, NGU, F.G, (int)blockIdx.x);
        pg8::EpiSwiGLU E{HB}; pg8::gemm_phase<pg8::EpiSwiGLU, pg8::StaticOrder, true, true>(F.lds + RING_OFF, g, S, E); GRID_BAR(); }
    if (IN(2)) { pg8::Gemm g{HB, (const bf16*)(ws + WS_WDA), M, D, FF}; pg8::StaticOrder S; S.init(M, D, F.G, (int)blockIdx.x);
        pg8::EpiResPre E{(const float*)args.in[0], (const float*)args.in[1], V, ALPHA, 0.5f}; pg8::gemm_phase<pg8::EpiResPre, pg8::StaticOrder, true, true>(F.lds + RING_OFF, g, S, E); GRID_BAR(); }
    if (IN(3)) { ln_phase(F, V, (const float*)args.in[10], (const float*)args.in[11], X1, X1 + (size_t)MP * D, XB); GRID_BAR(); }
    if (IN(4)) { pg8::Gemm g{XB, (const bf16*)(ws + WS_WIN), M, NINP, D}; pg8::StaticOrder S; S.init(M, NINP, F.G, (int)blockIdx.x);
        pg8::EpiInProj E{(const float*)(ws + WS_BIASP), (bf16*)(ws + WS_CB), (float*)(ws + WS_U), (bf16*)(ws + WS_Q), (bf16*)(ws + WS_KS), (bf16*)(ws + WS_KW), (float*)(ws + WS_G), out};
        pg8::gemm_phase<pg8::EpiInProj, pg8::StaticOrder, true, true>(F.lds + RING_OFF, g, S, E); GRID_BAR(); }
    if (IN(5)) {
        conv_phase(F, args);
#if !ATTN_PLACEHOLDER
#ifndef NO_COMPRESS
        compress_phase(F, args);
#endif
#endif
        GRID_BAR(); }
    if (IN(6)) {
#if ATTN_PLACEHOLDER
        { const int gt = F.vcu * (NWAVES * 64) + F.tid, NGT = F.G * NWAVES * 64;
          for (int i = gt; i < M * (DA / 8); i += NGT) { const int m = i / (DA / 8), c = i % (DA / 8); *(GAS v4u*)(A2 + (size_t)m * D + c * 8) = (v4u){0u, 0u, 0u, 0u}; }
          for (int i = gt; i < (M - MR) * (DC / 8); i += NGT) { const int m = MR + i / (DC / 8), c = i % (DC / 8); *(GAS v4u*)(A2 + (size_t)m * D + DA + c * 8) = (v4u){0u, 0u, 0u, 0u}; } }
#else
#ifndef NO_ATTN
        attn_phase(F, args);
#endif
#endif
        GRID_BAR(); }
    if (IN(7)) { pg8::Gemm g{A2, (const bf16*)(ws + WS_WOUT), M, D, D}; pg8::StaticOrder S; S.init(M, D, F.G, (int)blockIdx.x);
        pg8::EpiResPre E{X1, X1 + (size_t)MP * D, V, ALPHA, 1.0f}; pg8::gemm_phase<pg8::EpiResPre, pg8::StaticOrder, true, true>(F.lds + RING_OFF, g, S, E); GRID_BAR(); }
    if (IN(8)) { ln_phase(F, V, (const float*)args.in[19], (const float*)args.in[20], X2, X2 + (size_t)MP * D, XB); GRID_BAR(); }
    if (IN(9)) { pg8::Gemm g{XB, (const bf16*)(ws + WS_WGUB), M, NGU, D}; pg8::StaticOrder S; S.init(M, NGU, F.G, (int)blockIdx.x);
        pg8::EpiSwiGLU E{HB}; pg8::gemm_phase<pg8::EpiSwiGLU, pg8::StaticOrder, true, true>(F.lds + RING_OFF, g, S, E); GRID_BAR(); }
    if (IN(10)) { pg8::Gemm g{HB, (const bf16*)(ws + WS_WDB), M, D, FF}; pg8::StaticOrder S; S.init(M, D, F.G, (int)blockIdx.x);
        pg8::EpiResPre E{X2, X2 + (size_t)MP * D, V, ALPHA, 0.5f}; pg8::gemm_phase<pg8::EpiResPre, pg8::StaticOrder, true, true>(F.lds + RING_OFF, g, S, E); GRID_BAR(); }
    if (IN(11)) { ln_phase(F, V, (const float*)args.in[24], (const float*)args.in[25], out + O_YP, out + O_YS, nullptr); }
#undef IN
#undef GRID_BAR
}

extern "C" void kernel_launch(void* const* d_in, const int* in_sizes, int n_in, void* d_out, int out_size, void* d_ws, size_t ws_size, hipStream_t stream) {
    static int grid = 0;
    if (grid == 0) {
        if (n_in != 26 || (size_t)out_size != O_END || ws_size < WS_END) { fprintf(stderr, "kernel_launch: unexpected shapes (n_in %d out %d ws %zu)\n", n_in, out_size, ws_size); grid = -1; return; }
        int dev = 0, cus = 0, per_cu = 0;
        if (hipGetDevice(&dev) != hipSuccess || hipDeviceGetAttribute(&cus, hipDeviceAttributeMultiprocessorCount, dev) != hipSuccess) { grid = -1; return; }
        if (hipFuncSetAttribute((const void*)mk_fwd, hipFuncAttributeMaxDynamicSharedMemorySize, LDS_BYTES) != hipSuccess) { fprintf(stderr, "kernel_launch: hipFuncSetAttribute failed\n"); grid = -1; return; }
        if (hipOccupancyMaxActiveBlocksPerMultiprocessor(&per_cu, (const void*)mk_fwd, NWAVES * 64, LDS_BYTES) != hipSuccess || per_cu < 1)
            fprintf(stderr, "kernel_launch: occupancy query reports %d workgroups per CU\n", per_cu);
        (void)hipGetLastError();
        grid = cus;
    }
    if (grid < 0) return;
    if (hipMemsetAsync((char*)d_ws + WS_CTL, 0, CTL_ZERO_BYTES, stream) != hipSuccess) return;
    KArgs a{};
    for (int i = 0; i < 26; ++i) a.in[i] = d_in[i];
    a.out = (float*)d_out; a.ws = (unsigned char*)d_ws; a.ph_lo = 0; a.ph_hi = 12;
    hipLaunchKernelGGL(mk_fwd, dim3(grid), dim3(NWAVES * 64), LDS_BYTES, stream, a);
}
```

```cpp
#include <hip/hip_runtime.h>
#include <cstdio>
#include <cstdint>
namespace pg8 {
#define PG8_LAS __attribute__((address_space(3)))
typedef unsigned short bf16_t;
typedef short bf16x8 __attribute__((ext_vector_type(8)));
typedef float f32x4 __attribute__((ext_vector_type(4)));
typedef unsigned u32x4 __attribute__((ext_vector_type(4)));
constexpr int BM = 256, BK = 64, HALF = 128, HTB = HALF * BK * 2  , STAGE_BYTES = 8 * HTB, NXCD = 8, WGM = 8;

__host__ __device__ __forceinline__ int lds_byte(int r, int c) { const int st = (r >> 4) * 2 + (c >> 5), rr = r & 15, cc = c & 31, ob = rr * 64 + cc * 2; return st * 1024 + (ob ^ (((ob >> 9) & 1) << 5)); }
__host__ __device__ __forceinline__ void stage_rc(int b, int& R, int& C) { const int st = b / 1024, sb = b % 1024, swz = sb ^ (((sb >> 9) & 1) << 5); R = (st >> 1) * 16 + swz / 64; C = (st & 1) * 32 + (swz % 64) / 2; }
__host__ __device__ __forceinline__ int perm32(int rho) { const int n = rho >> 4, i = rho & 15; return 8 * (i >> 2) + 4 * n + (i & 3); }

struct Unit { int pm, pn; };
struct Gemm { const bf16_t* A; const bf16_t* Bt; int M, N, K; };

struct StaticOrder {
    int nM, nN, nwg, G, c;
    __host__ __device__ void init(int M, int N, int G_, int c_) { nM = M / BM; nN = N / BM; nwg = nM * nN; G = G_; c = c_; }
    __host__ __device__ bool next(int i, Unit& u) const {
        const long L = (long)i * G + c; if (L >= nwg) return false;
        int wgid = (int)L; { const int q = nwg / NXCD, r = nwg % NXCD, xcd = wgid % NXCD, off = wgid / NXCD; wgid = (xcd < r ? xcd * (q + 1) : r * (q + 1) + (xcd - r) * q) + off; }
        const int nig = WGM * nN, gid = wgid / nig, fm = gid * WGM, gsz = (nM - fm) < WGM ? (nM - fm) : WGM;
        u.pm = fm + ((wgid % nig) % gsz); u.pn = (wgid % nig) / gsz; return true;
    }
    __device__ __forceinline__ void a_ready(const Unit&) const {}
    __device__ __forceinline__ void done(const Unit&) const {}
};

__device__ __forceinline__ unsigned cvt_pk_bf16(float lo, float hi) { unsigned r; asm volatile("v_cvt_pk_bf16_f32 %0, %1, %2" : "=v"(r) : "v"(lo), "v"(hi)); return r; }
typedef float f32x2 __attribute__((ext_vector_type(2)));
template <class Epi, class Sched, bool ALIGN_EPI = false, bool SP2 = false>
__device__ __forceinline__ void gemm_phase(PG8_LAS unsigned char* lds, const Gemm g, const Sched& S, const Epi& E) {
    const int tid = threadIdx.x, wid = __builtin_amdgcn_readfirstlane(tid >> 6), lane = tid & 63, wr = wid >> 2, wc = wid & 3, fr = lane & 15, fq = lane >> 4;
    const int K = g.K, nt = K / BK;
    unsigned voffA[2], voffB[2];
#pragma unroll
    for (int i = 0; i < 2; ++i) { int R, C; stage_rc(tid * 16 + i * 8192, R, C); const int Rb = Epi::PERM ? ((R & ~31) + perm32(R & 31)) : R;
        voffA[i] = (unsigned)(R * K + C) * 2u; voffB[i] = (unsigned)(Rb * K + C) * 2u; }
    const size_t kstep = (size_t)(BK * 2);
    const size_t hstep = (size_t)HALF * K * 2;
    const size_t tstep = 2 * hstep;
    const unsigned ldsw = (unsigned)wid * 1024u;
    const int aoff = lds_byte(wr * 64 + fr, fq * 8), boff = lds_byte(wc * 32 + fr, fq * 8);
#define PG8_SA(b, h) (((b) * 2 + (h)) * HTB)
#define PG8_SB(b, h) ((4 + (b) * 2 + (h)) * HTB)
#define PG8_STAGE(bufoff, gbase, voff) do { _Pragma("unroll") for (int _i = 0; _i < 2; ++_i) \
        __builtin_amdgcn_global_load_lds((const unsigned*)((const char*)(gbase) + (voff)[_i]), (PG8_LAS unsigned*)(lds + (bufoff) + ldsw + _i * 8192), 16, 0, 0); } while (0)
#define PG8_LDA(dst, b, h) do { _Pragma("unroll") for (int m = 0; m < 4; ++m) _Pragma("unroll") for (int k = 0; k < 2; ++k) dst[m][k] = *(const PG8_LAS bf16x8*)(lds + PG8_SA(b, h) + aoff + m * 2048 + k * 1024); } while (0)
#define PG8_LDB(dst, b, h) do { _Pragma("unroll") for (int n = 0; n < 2; ++n) _Pragma("unroll") for (int k = 0; k < 2; ++k) dst[n][k] = *(const PG8_LAS bf16x8*)(lds + PG8_SB(b, h) + boff + n * 2048 + k * 1024); } while (0)
#define PG8_MMA(ai, bj, At, Bt) do { __builtin_amdgcn_s_setprio(1); _Pragma("unroll") for (int m = 0; m < 4; ++m) _Pragma("unroll") for (int n = 0; n < 2; ++n) _Pragma("unroll") for (int k = 0; k < 2; ++k) \
        acc[ai][bj][m][n] = __builtin_amdgcn_mfma_f32_16x16x32_bf16(Bt[n][k], At[m][k], acc[ai][bj][m][n], 0, 0, 0); __builtin_amdgcn_s_setprio(0); } while (0)
#define PG8_WAIT_V(n) asm volatile("s_waitcnt vmcnt(" #n ")" ::: "memory")
#define PG8_WAIT_L(n) asm volatile("s_waitcnt lgkmcnt(" #n ")" ::: "memory")
#define PG8_BAR __builtin_amdgcn_s_barrier()
#define PG8_SCHED __builtin_amdgcn_sched_barrier(0)
    Unit cur, nxt; int ui = 0;
    if (!S.next(0, cur)) return;
    f32x4 acc[2][2][4][2];
#pragma unroll
    for (int a = 0; a < 2; ++a)
#pragma unroll
        for (int b = 0; b < 2; ++b)
#pragma unroll
            for (int m = 0; m < 4; ++m)
#pragma unroll
                for (int n = 0; n < 2; ++n) acc[a][b][m][n] = (f32x4){0.f, 0.f, 0.f, 0.f};
    bf16x8 At[4][2], B0[2][2], B1[2][2];
    const char* cA = (const char*)g.A + (size_t)cur.pm * tstep; const char* cB = (const char*)g.Bt + (size_t)cur.pn * tstep;
    S.a_ready(cur);
    if constexpr (SP2) {
        PG8_STAGE(PG8_SB(0, 0), cB, voffB); PG8_STAGE(PG8_SB(0, 1), cB + hstep, voffB); PG8_STAGE(PG8_SA(0, 0), cA, voffA); PG8_STAGE(PG8_SA(0, 1), cA + hstep, voffA);
        if (wr == 1) PG8_BAR;
        PG8_WAIT_V(2); PG8_BAR;
        PG8_STAGE(PG8_SB(1, 0), cB + kstep, voffB); PG8_STAGE(PG8_SA(1, 0), cA + kstep, voffA); PG8_STAGE(PG8_SB(1, 1), cB + hstep + kstep, voffB);
        PG8_WAIT_V(6); PG8_BAR;
    } else {
        PG8_STAGE(PG8_SB(0, 0), cB, voffB); PG8_STAGE(PG8_SA(0, 0), cA, voffA); PG8_STAGE(PG8_SB(0, 1), cB + hstep, voffB); PG8_STAGE(PG8_SA(0, 1), cA + hstep, voffA);
        if (wr == 1) PG8_BAR;
        PG8_WAIT_V(4); PG8_BAR;
        PG8_STAGE(PG8_SB(1, 0), cB + kstep, voffB); PG8_STAGE(PG8_SA(1, 0), cA + kstep, voffA); PG8_STAGE(PG8_SB(1, 1), cB + hstep + kstep, voffB);
        PG8_WAIT_V(6); PG8_BAR;
    }
    for (;;) {
        const bool has_next = S.next(ui + 1, nxt);
        const char* nA = has_next ? (const char*)g.A + (size_t)nxt.pm * tstep : cA; const char* nB = has_next ? (const char*)g.Bt + (size_t)nxt.pn * tstep : cB;
        for (int t = 0; t < nt; t += 2) {
            const bool last = (t == nt - 2);
            const char* a1 = cA + (size_t)(t + 1) * kstep;
            const char* a2 = last ? nA : cA + (size_t)(t + 2) * kstep; const char* b2 = last ? nB : cB + (size_t)(t + 2) * kstep;
            const char* a3 = a2 + kstep; const char* b3 = b2 + kstep;
            if (last && has_next) S.a_ready(nxt);
            if constexpr (SP2) {
            PG8_LDB(B0, 0, 0); PG8_LDB(B1, 0, 1); PG8_SCHED; PG8_LDA(At, 0, 0); PG8_STAGE(PG8_SA(1, 1), a1 + hstep, voffA);
            PG8_WAIT_V(8); PG8_WAIT_L(0); PG8_BAR; PG8_MMA(0, 0, At, B0); PG8_MMA(0, 1, At, B1); PG8_BAR; PG8_SCHED;
            PG8_LDA(At, 0, 1); PG8_STAGE(PG8_SB(0, 0), b2, voffB); PG8_STAGE(PG8_SB(0, 1), b2 + hstep, voffB); PG8_STAGE(PG8_SA(0, 0), a2, voffA);
            PG8_WAIT_V(8); PG8_WAIT_L(0); PG8_BAR; PG8_MMA(1, 0, At, B0); PG8_MMA(1, 1, At, B1); PG8_BAR; PG8_SCHED;
            PG8_LDB(B0, 1, 0); PG8_LDB(B1, 1, 1); PG8_SCHED; PG8_LDA(At, 1, 0); PG8_STAGE(PG8_SA(0, 1), a2 + hstep, voffA);
            PG8_WAIT_V(8); PG8_WAIT_L(0); PG8_BAR; PG8_MMA(0, 0, At, B0); PG8_MMA(0, 1, At, B1); PG8_BAR; PG8_SCHED;
            PG8_LDA(At, 1, 1); PG8_STAGE(PG8_SB(1, 0), b3, voffB); PG8_STAGE(PG8_SB(1, 1), b3 + hstep, voffB); PG8_STAGE(PG8_SA(1, 0), a3, voffA);
            PG8_WAIT_V(8); PG8_WAIT_L(0); PG8_BAR; PG8_MMA(1, 0, At, B0); PG8_MMA(1, 1, At, B1); PG8_BAR; PG8_SCHED;
            } else {
            PG8_LDB(B0, 0, 0); PG8_SCHED; PG8_LDA(At, 0, 0); PG8_STAGE(PG8_SA(1, 1), a1 + hstep, voffA);
            PG8_WAIT_L(8); PG8_BAR; PG8_WAIT_L(0); PG8_MMA(0, 0, At, B0); PG8_BAR; PG8_SCHED;
            PG8_LDB(B1, 0, 1); PG8_STAGE(PG8_SB(0, 0), b2, voffB);
            PG8_BAR; PG8_WAIT_L(0); PG8_MMA(0, 1, At, B1); PG8_BAR;
            PG8_LDA(At, 0, 1); PG8_STAGE(PG8_SA(0, 0), a2, voffA);
            PG8_BAR; PG8_WAIT_L(0); PG8_MMA(1, 0, At, B0); PG8_BAR; PG8_SCHED;
            PG8_STAGE(PG8_SB(0, 1), b2 + hstep, voffB);
            PG8_WAIT_V(6); PG8_BAR; PG8_MMA(1, 1, At, B1); PG8_BAR;
            PG8_LDB(B0, 1, 0); PG8_SCHED; PG8_LDA(At, 1, 0); PG8_STAGE(PG8_SA(0, 1), a2 + hstep, voffA);
            PG8_WAIT_L(8); PG8_BAR; PG8_WAIT_L(0); PG8_MMA(0, 0, At, B0); PG8_BAR; PG8_SCHED;
            PG8_LDB(B1, 1, 1); PG8_STAGE(PG8_SB(1, 0), b3, voffB);
            PG8_BAR; PG8_WAIT_L(0); PG8_MMA(0, 1, At, B1); PG8_BAR;
            PG8_LDA(At, 1, 1); PG8_STAGE(PG8_SA(1, 0), a3, voffA);
            PG8_BAR; PG8_WAIT_L(0); PG8_MMA(1, 0, At, B0); PG8_BAR; PG8_SCHED;
            PG8_STAGE(PG8_SB(1, 1), b3 + hstep, voffB);
            PG8_WAIT_V(6); PG8_BAR; PG8_MMA(1, 1, At, B1); PG8_BAR;
            }
        }
        if constexpr (ALIGN_EPI) { if (wr == 0) PG8_BAR; }
        if constexpr (!Epi::AFTER_DRAIN) { E(acc, cur, wr, wc, fr, fq); S.done(cur); }
        if (!has_next) break;
#pragma unroll
        for (int a = 0; a < 2; ++a)
#pragma unroll
            for (int b = 0; b < 2; ++b)
#pragma unroll
                for (int m = 0; m < 4; ++m)
#pragma unroll
                    for (int n = 0; n < 2; ++n) acc[a][b][m][n] = (f32x4){0.f, 0.f, 0.f, 0.f};
        cur = nxt; cA = nA; cB = nB; ++ui;
        if constexpr (ALIGN_EPI) { if (wr == 1) PG8_BAR; }
    }
    PG8_WAIT_V(0);
    if constexpr (!ALIGN_EPI) { if (wr == 0) PG8_BAR; }
    PG8_BAR;
    if constexpr (Epi::AFTER_DRAIN) { E.fused(acc, cur, wr, wc, fr, fq, lds, wid, lane); S.done(cur); }
#undef PG8_SA
#undef PG8_SB
#undef PG8_STAGE
#undef PG8_LDA
#undef PG8_LDB
#undef PG8_MMA
#undef PG8_WAIT_V
#undef PG8_WAIT_L
#undef PG8_BAR
#undef PG8_SCHED
}
}
constexpr int NWAVES = 8;
constexpr int D = 1024, FF = 2816, NGU = 2 * FF, NINP = 3072, DIN = 2840;
constexpr int NB = 16, T = 2048, MP = NB * T, SB = 32, SS = 4, MS = SB * SS, MR = MP + MS, M = 33024;
constexpr int DC = 512, DA = 512, HD = 64, NH = 8, NKV = 2, KVW = 256;
constexpr int PAST = 16384, PAGE = 128, NPAGES = PAST / PAGE, BLK = 64, NSEL = 16, WIN = 512;
constexpr int NBP = T / BLK  , NBS = PAST / BLK  ;
constexpr float ALPHA = 1.189207115002721f, LN_EPS = 1e-5f;
constexpr float QSCALE = 0.125f * 1.4426950408889634f;
constexpr size_t O_YP = 0, O_YS = (size_t)MP * D, O_PCMP = O_YS + (size_t)MS * D, O_PSEL = O_PCMP + (size_t)MP * KVW, O_PWIN = O_PSEL + (size_t)MP * KVW,
                 O_PCONV = O_PWIN + (size_t)NB * WIN * KVW, O_SCMP = O_PCONV + (size_t)NB * 2 * DC, O_SSEL = O_SCMP + (size_t)MS * KVW, O_SWIN = O_SSEL + (size_t)MS * KVW,
                 O_SCONV = O_SWIN + (size_t)SB * WIN * KVW, O_END = O_SCONV + (size_t)SB * 2 * DC;
static_assert(O_END == 56868864, "output size");
constexpr size_t MiB = 1u << 20;
constexpr size_t WS_CTL = 0, CTL_ZERO_BYTES = 1 * MiB;
constexpr size_t WS_WGUA = 2 * MiB, WS_WDA = 14 * MiB, WS_WIN = 20 * MiB, WS_WOUT = 26 * MiB, WS_WGUB = 28 * MiB, WS_WDB = 40 * MiB, WS_W1T = 46 * MiB, WS_BIASP = 47 * MiB;
constexpr size_t WS_KC = 48 * MiB;
constexpr size_t WS_XB = 64 * MiB;
constexpr size_t WS_H = 130 * MiB;
constexpr size_t WS_V = 308 * MiB;
constexpr size_t WS_X1 = 438 * MiB, WS_X2 = 568 * MiB;
constexpr size_t WS_CB = 698 * MiB;
constexpr size_t WS_U = 731 * MiB;
constexpr size_t WS_Q = 796 * MiB;
constexpr size_t WS_KS = 829 * MiB, WS_KW = 846 * MiB;
constexpr size_t WS_G = 863 * MiB;
constexpr size_t WS_A2 = 868 * MiB;
constexpr size_t WS_SELM = 933 * MiB;
constexpr size_t WS_END = 940 * MiB;
constexpr int CW_TMO = 0, CW_CODE = 1, CW_BAR = 4096;
constexpr int RING_OFF = 0, RING_BYTES = 131072;
constexpr int LDSCTL_OFF = RING_BYTES, MISC_OFF = LDSCTL_OFF + 320;
constexpr int LDS_BYTES = 147456;
namespace pg8 {
typedef unsigned u32x2 __attribute__((ext_vector_type(2)));
__device__ __forceinline__ float silu_mul(float g, float u) { return g * u * __builtin_amdgcn_rcpf(1.0f + __builtin_amdgcn_exp2f(-1.4426950408889634f * g)); }
struct EpiSwiGLU {
    static constexpr bool PERM = true, AFTER_DRAIN = false;
    bf16_t* H;
    __device__ __forceinline__ void operator()(const f32x4 (&acc)[2][2][4][2], const Unit& u, int wr, int wc, int fr, int fq) const {
        const int row0 = u.pm * BM + wr * 64 + fr, col0 = u.pn * HALF + wc * 32 + 8 * fq;
#pragma unroll
        for (int ai = 0; ai < 2; ++ai)
#pragma unroll
            for (int m = 0; m < 4; ++m) {
                const f32x4 g0 = acc[ai][0][m][0], g1 = acc[ai][0][m][1], u0 = acc[ai][1][m][0], u1 = acc[ai][1][m][1];
                u32x4 w;
                w.x = cvt_pk_bf16(silu_mul(g0[0], u0[0]), silu_mul(g0[1], u0[1])); w.y = cvt_pk_bf16(silu_mul(g0[2], u0[2]), silu_mul(g0[3], u0[3]));
                w.z = cvt_pk_bf16(silu_mul(g1[0], u1[0]), silu_mul(g1[1], u1[1])); w.w = cvt_pk_bf16(silu_mul(g1[2], u1[2]), silu_mul(g1[3], u1[3]));
                *(u32x4*)(H + (size_t)(row0 + ai * HALF + m * 16) * FF + col0) = w;
            }
    }
};
struct EpiResPre {
    static constexpr bool PERM = false, AFTER_DRAIN = false;
    const float* base_p; const float* base_s; float* V; float alpha, s;
    __device__ __forceinline__ void operator()(const f32x4 (&acc)[2][2][4][2], const Unit& u, int wr, int wc, int fr, int fq) const {
        const int col0 = u.pn * BM + wc * 32 + 4 * fq;
        const bool sp = (u.pm == MP / BM);
#pragma unroll
        for (int ai = 0; ai < 2; ++ai) {
            if (sp && ai == 1) continue;
#pragma unroll
            for (int m = 0; m < 4; ++m) {
                const int r = u.pm * BM + ai * HALF + wr * 64 + m * 16 + fr;
                const float* brow = sp ? base_s + (size_t)(r - MP) * D : base_p + (size_t)r * D;
                float* vrow = V + (size_t)r * D;
#pragma unroll
                for (int bj = 0; bj < 2; ++bj)
#pragma unroll
                    for (int n = 0; n < 2; ++n) { const int c = col0 + bj * HALF + n * 16; const f32x4 x = *(const f32x4*)(brow + c);
                        *(f32x4*)(vrow + c) = x * alpha + acc[ai][bj][m][n] * s; }
            }
        }
    }
};
struct EpiInProj {
    static constexpr bool PERM = false, AFTER_DRAIN = false;
    const float* biasp; bf16_t* CB; float* U; bf16_t* Q; bf16_t* KS; bf16_t* KW; float* G; float* out;
    __device__ __forceinline__ void operator()(const f32x4 (&acc)[2][2][4][2], const Unit& u, int wr, int wc, int fr, int fq) const {
        const int pn = u.pn; const bool sp = (u.pm == MP / BM);
        const int cl = wc * 32 + 4 * fq;
        f32x4 bv[2][2];
#pragma unroll
        for (int bj = 0; bj < 2; ++bj)
#pragma unroll
            for (int n = 0; n < 2; ++n) bv[bj][n] = *(const f32x4*)(biasp + pn * BM + bj * HALF + cl + n * 16);
#pragma unroll
        for (int ai = 0; ai < 2; ++ai) {
            if (sp && ai == 1) continue;
#pragma unroll
            for (int m = 0; m < 4; ++m) {
                const int r = u.pm * BM + ai * HALF + wr * 64 + m * 16 + fr;
                const int si = r - MP;
                const int tb = r & (T - 1), nb = r >> 11;
                if (pn < 2) {
#pragma unroll
                    for (int bj = 0; bj < 2; ++bj)
#pragma unroll
                        for (int n = 0; n < 2; ++n) { const f32x4 v = acc[ai][bj][m][n] + bv[bj][n]; u32x2 w; w.x = cvt_pk_bf16(v[0], v[1]); w.y = cvt_pk_bf16(v[2], v[3]);
                            *(u32x2*)(CB + (size_t)r * DC + pn * BM + bj * HALF + cl + n * 16) = w; }
                } else if (pn < 6) {
#pragma unroll
                    for (int n = 0; n < 2; ++n) { const f32x4 v = (acc[ai][0][m][n] + bv[0][n]) * (acc[ai][1][m][n] + bv[1][n]); const int ch = (pn - 2) * HALF + cl + n * 16;
                        *(f32x4*)(U + (size_t)r * DC + ch) = v;
                        if (!sp) { if (tb >= T - 2) *(f32x4*)(out + O_PCONV + (size_t)(nb * 2 + (tb - (T - 2))) * DC + ch) = v; }
                        else { const int s = si & 3; if (s >= 2) *(f32x4*)(out + O_SCONV + (size_t)((si >> 2) * 2 + (s - 2)) * DC + ch) = v; } }
                } else if (pn < 8) {
#pragma unroll
                    for (int bj = 0; bj < 2; ++bj)
#pragma unroll
                        for (int n = 0; n < 2; ++n) { const f32x4 v = (acc[ai][bj][m][n] + bv[bj][n]) * QSCALE; u32x2 w; w.x = cvt_pk_bf16(v[0], v[1]); w.y = cvt_pk_bf16(v[2], v[3]);
                            *(u32x2*)(Q + (size_t)r * DA + (pn - 6) * BM + bj * HALF + cl + n * 16) = w; }
                } else if (pn == 8) {
                    float* o = sp ? out + O_SCMP + (size_t)si * KVW : out + O_PCMP + (size_t)r * KVW;
#pragma unroll
                    for (int bj = 0; bj < 2; ++bj)
#pragma unroll
                        for (int n = 0; n < 2; ++n) *(f32x4*)(o + bj * HALF + cl + n * 16) = acc[ai][bj][m][n] + bv[bj][n];
                } else if (pn == 9) {
                    float* o = sp ? out + O_SSEL + (size_t)si * KVW : out + O_PSEL + (size_t)r * KVW;
#pragma unroll
                    for (int bj = 0; bj < 2; ++bj)
#pragma unroll
                        for (int n = 0; n < 2; ++n) { const f32x4 v = acc[ai][bj][m][n] + bv[bj][n]; *(f32x4*)(o + bj * HALF + cl + n * 16) = v;
                            u32x2 w; w.x = cvt_pk_bf16(v[0], v[1]); w.y = cvt_pk_bf16(v[2], v[3]); *(u32x2*)(KS + (size_t)r * KVW + bj * HALF + cl + n * 16) = w; }
                } else if (pn == 10) {
                    float* o = nullptr;
                    if (sp) o = out + O_SWIN + (size_t)((si >> 2) * WIN + (WIN - SS) + (si & 3)) * KVW;
                    else if (tb >= T - WIN) o = out + O_PWIN + (size_t)(nb * WIN + tb - (T - WIN)) * KVW;
#pragma unroll
                    for (int bj = 0; bj < 2; ++bj)
#pragma unroll
                        for (int n = 0; n < 2; ++n) { const f32x4 v = acc[ai][bj][m][n] + bv[bj][n]; if (o) *(f32x4*)(o + bj * HALF + cl + n * 16) = v;
                            u32x2 w; w.x = cvt_pk_bf16(v[0], v[1]); w.y = cvt_pk_bf16(v[2], v[3]); *(u32x2*)(KW + (size_t)r * KVW + bj * HALF + cl + n * 16) = w; }
                } else {
                    if (wc == 0) {
#pragma unroll
                        for (int n = 0; n < 2; ++n) { if (n == 1 && fq >= 2) continue; f32x4 v = acc[ai][0][m][n] + bv[0][n];
#pragma unroll
                            for (int j = 0; j < 4; ++j) v[j] = __builtin_amdgcn_rcpf(1.0f + __builtin_amdgcn_exp2f(-1.4426950408889634f * v[j]));
                            *(f32x4*)(G + (size_t)r * 32 + cl + n * 16) = v; }
                    }
                }
            }
        }
    }
};
}
#define GAS __attribute__((address_space(1)))
#define LAS __attribute__((address_space(3)))
typedef unsigned short bf16;
typedef unsigned v4u __attribute__((ext_vector_type(4)));
typedef float f32x4 __attribute__((ext_vector_type(4)));
typedef short bf16x8 __attribute__((ext_vector_type(8)));
typedef GAS unsigned gu32;
typedef GAS unsigned long long gu64;
#define RLX_AGENT __ATOMIC_RELAXED, __HIP_MEMORY_SCOPE_AGENT
#define LDS_WAIT() asm volatile("s_waitcnt lgkmcnt(0)" ::: "memory")
#define VM_WAIT() asm volatile("s_waitcnt vmcnt(0)" ::: "memory")
__device__ __forceinline__ unsigned long long rt() { return __builtin_amdgcn_s_memrealtime(); }
__device__ __forceinline__ unsigned f2bf(float f) { unsigned u = __builtin_bit_cast(unsigned, f); return (u + 0x7fffu + ((u >> 16) & 1u)) >> 16; }
__device__ __forceinline__ unsigned pk2(float lo, float hi) { return f2bf(lo) | (f2bf(hi) << 16); }
#define XB_TMO      128
#define XB_XCNT(j)  (256  + 64 * (j))
#define XB_XSUB(j)  (1280 + 64 * (j))
#define XB_XGEN(j)  (2304 + 64 * (j))
#define XB_TOP      3328
#define XB_TOPGEN   3392
#define XCD_BAR_WORDS 3456
#define XB_SPIN_CAP (1u << 18)

__device__ __forceinline__ unsigned xb_ld(unsigned* p)              { return __hip_atomic_load(p, __ATOMIC_RELAXED, __HIP_MEMORY_SCOPE_AGENT); }
__device__ __forceinline__ unsigned xb_add(unsigned* p, unsigned v) { return __hip_atomic_fetch_add(p, v, __ATOMIC_RELAXED, __HIP_MEMORY_SCOPE_AGENT); }
__device__ __forceinline__ unsigned xb_xcc_id() { return (unsigned)__builtin_amdgcn_s_getreg((3 << 11) | 20) & 0xFu; }
#define XB_SPIN(cond, bar) do { unsigned _sp = 0; while (cond) { __builtin_amdgcn_s_sleep(1); \
    if ((++_sp & 255u) == 0u) { if (xb_ld(&(bar)[XB_TMO])) break; if (_sp > XB_SPIN_CAP) { atomicAdd(&(bar)[XB_TMO], 1u); break; } } } } while (0)

struct XcdBarrier {
    unsigned* bar; unsigned x;
    volatile LAS unsigned* st;
};

__device__ __forceinline__ XcdBarrier xcd_barrier_post(unsigned* bar, volatile LAS unsigned* st) {
    XcdBarrier b; b.bar = bar; b.x = xb_xcc_id(); b.st = st;
    if (threadIdx.x == 0) (void)xb_add(&bar[XB_XCNT(b.x)], 1u);
    return b;
}
__device__ __forceinline__ void xcd_barrier_complete(unsigned* bar, unsigned x, unsigned& nloc, unsigned& nx) {
    const unsigned G = gridDim.x * gridDim.y * gridDim.z;
    unsigned sum, cnt, mine, sp = 0u;
    for (;;) {
        sum = 0u; cnt = 0u; mine = 0u;
#pragma unroll
        for (unsigned j = 0; j < 16; ++j) { const unsigned c = xb_ld(&bar[XB_XCNT(j)]); sum += c; cnt += (c > 0u) ? 1u : 0u; mine = (j == x) ? c : mine; }
        if (sum == G) break;
        __builtin_amdgcn_s_sleep(1);
        if ((++sp & 255u) == 0u) { if (xb_ld(&bar[XB_TMO])) break; if (sp > XB_SPIN_CAP) { atomicAdd(&bar[XB_TMO], 1u); break; } }
    }
    nloc = mine > 0u ? mine : 1u; nx = cnt > 0u ? cnt : 1u;
}

__device__ __forceinline__ void xcd_barrier(const XcdBarrier& b) {
    asm volatile("s_waitcnt vmcnt(0)" ::: "memory");
    __syncthreads();
    if (threadIdx.x == 0) {
        unsigned* bar = b.bar;
        __builtin_amdgcn_s_waitcnt(0);
        unsigned nloc = b.st[0], nx = b.st[1];
        if (nloc == 0u) { xcd_barrier_complete(bar, b.x, nloc, nx); b.st[0] = nloc; b.st[1] = nx; }
        const unsigned old = xb_add(&bar[XB_XSUB(b.x)], 1u);
        const unsigned gen = old / nloc;
        if (old + 1u == (gen + 1u) * nloc) {
            __builtin_amdgcn_fence(__ATOMIC_RELEASE, "agent");
            asm volatile("s_waitcnt vmcnt(0)" ::: "memory");
            const unsigned og = xb_add(&bar[XB_TOP], 1u);
            const unsigned tg = og / nx;
            if (og + 1u == (tg + 1u) * nx) xb_add(&bar[XB_TOPGEN], 1u);
            else XB_SPIN(xb_ld(&bar[XB_TOPGEN]) == tg, bar);
            __builtin_amdgcn_fence(__ATOMIC_ACQUIRE, "agent");
            xb_add(&bar[XB_XGEN(b.x)], 1u);
            asm volatile("s_waitcnt vmcnt(0)" ::: "memory");
        } else {
            XB_SPIN(xb_ld(&bar[XB_XGEN(b.x)]) == gen, bar);
            __builtin_amdgcn_fence(__ATOMIC_ACQUIRE, "agent");
            asm volatile("s_waitcnt vmcnt(0)" ::: "memory");
        }
    }
    __syncthreads();
}
struct Frame {
    LAS unsigned char* lds;
    volatile LAS unsigned* MISC;
    gu32* ctl;
    int tid, lane, wave;
    int vcu, G;
};
__device__ __forceinline__ float wave_sum(float v) {
#pragma unroll
    for (int o = 1; o < 64; o <<= 1) v += __shfl_xor(v, o);
    return v;
}
__device__ __forceinline__ float wave_max(float v) {
#pragma unroll
    for (int o = 1; o < 64; o <<= 1) v = fmaxf(v, __shfl_xor(v, o));
    return v;
}
__device__ __forceinline__ void p0_transpose_item(const float* W, int K, int N, bf16* WT, int dst_row0, int k0, int n0, int nvalid, LAS float* scr, int lane) {
#pragma unroll 8
    for (int i = 0; i < 32; ++i) { const int kk = 2 * i + (lane >> 5); const int n = lane & 31; scr[kk * 33 + n] = (n < nvalid) ? W[(size_t)(k0 + kk) * N + n0 + n] : 0.f; }
    LDS_WAIT(); asm volatile("" ::: "memory");
    const int c = lane & 7;
#pragma unroll
    for (int j = 0; j < 4; ++j) { const int n = (lane >> 3) + 8 * j; const LAS float* s = scr + (8 * c) * 33 + n;
        v4u o; o.x = pk2(s[0 * 33], s[1 * 33]); o.y = pk2(s[2 * 33], s[3 * 33]); o.z = pk2(s[4 * 33], s[5 * 33]); o.w = pk2(s[6 * 33], s[7 * 33]);
        *(GAS v4u*)(WT + (size_t)(dst_row0 + n) * K + k0 + 8 * c) = o; }
    LDS_WAIT(); asm volatile("" ::: "memory");
}
__device__ __forceinline__ int map_gu(int n0, int up) { return 256 * (n0 >> 7) + (n0 & 127) + (up ? 128 : 0); }
__device__ __forceinline__ int map_in(int n0) {
    if (n0 < 512) return n0;
    if (n0 < 1024) { const int ch = n0 - 512; return 512 + 256 * (ch >> 7) + (ch & 127); }
    if (n0 < 1536) { const int ch = n0 - 1024; return 512 + 256 * (ch >> 7) + 128 + (ch & 127); }
    return n0;
}
__device__ __forceinline__ int unmap_in(int r) {
    if (r < 512) return r;
    if (r < 1536) { const int t = (r - 512) >> 8, w = (r - 512) & 255; return w < 128 ? 512 + 128 * t + w : 1024 + 128 * t + (w - 128); }
    if (r < DIN) return r;
    return -1;
}
struct KArgs { const void* in[26]; float* out; unsigned char* ws; int ph_lo, ph_hi; };
__device__ __forceinline__ void p0_prologue(Frame& F, const KArgs& a) {
    LAS float* scr = (LAS float*)(F.lds + RING_OFF + F.wave * 16384);
    const int gw = F.vcu * NWAVES + F.wave, NGW = F.G * NWAVES;
    unsigned char* ws = a.ws;
    constexpr int I_GU = (D / 64) * (FF / 32), I_DN = (FF / 64) * (D / 32), I_IN = (D / 64) * ((DIN + 31) / 32), I_OUT = (D / 64) * (D / 32), I_W1 = (4096 / 64) * (64 / 32);
    constexpr int NITEMS = 4 * I_GU + 2 * I_DN + I_IN + I_OUT + 2 * I_W1;
    for (int it = gw; it < NITEMS; it += NGW) {
        int r = it;
        if (r < 4 * I_GU) { const int which = r / I_GU; r -= which * I_GU;
            const float* W = (const float*)a.in[which == 0 ? 7 : which == 1 ? 8 : which == 2 ? 21 : 22]; bf16* WT = (bf16*)(ws + (which < 2 ? WS_WGUA : WS_WGUB));
            const int nblk = FF / 32, kb = r / nblk, nb = r % nblk; p0_transpose_item(W, D, FF, WT, map_gu(32 * nb, which & 1), 64 * kb, 32 * nb, 32, scr, F.lane); continue; }
        r -= 4 * I_GU;
        if (r < 2 * I_DN) { const int which = r / I_DN; r -= which * I_DN;
            const float* W = (const float*)a.in[which == 0 ? 9 : 23]; bf16* WT = (bf16*)(ws + (which == 0 ? WS_WDA : WS_WDB));
            const int nblk = D / 32, kb = r / nblk, nb = r % nblk; p0_transpose_item(W, FF, D, WT, 32 * nb, 64 * kb, 32 * nb, 32, scr, F.lane); continue; }
        r -= 2 * I_DN;
        if (r < I_IN) { const int nblk = (DIN + 31) / 32, kb = r / nblk, nb = r % nblk; const int nv = (DIN - 32 * nb) < 32 ? (DIN - 32 * nb) : 32;
            p0_transpose_item((const float*)a.in[12], D, DIN, (bf16*)(ws + WS_WIN), map_in(32 * nb), 64 * kb, 32 * nb, nv, scr, F.lane); continue; }
        r -= I_IN;
        if (r < I_OUT) { const int nblk = D / 32, kb = r / nblk, nb = r % nblk; p0_transpose_item((const float*)a.in[18], D, D, (bf16*)(ws + WS_WOUT), 32 * nb, 64 * kb, 32 * nb, 32, scr, F.lane); continue; }
        r -= I_OUT;
        { const int c = r / I_W1; r -= c * I_W1; const int kb = r / 2, nb = r % 2;
          p0_transpose_item((const float*)a.in[15] + (size_t)c * 4096 * 64, 4096, 64, (bf16*)(ws + WS_W1T) + (size_t)c * 64 * 4096, 32 * nb, 64 * kb, 32 * nb, 32, scr, F.lane); }
    }
    { const int gt = F.vcu * (NWAVES * 64) + F.tid, NGT = F.G * NWAVES * 64;
      for (int i = gt; i < NINP; i += NGT) { const int s = unmap_in(i); ((float*)(ws + WS_BIASP))[i] = s >= 0 ? ((const float*)a.in[13])[s] : 0.f; }
      constexpr int ZR0 = ((DIN + 31) / 32) * 32; GAS v4u* z = (GAS v4u*)((bf16*)(ws + WS_WIN) + (size_t)ZR0 * D);
      for (int i = gt; i < (NINP - ZR0) * D / 8; i += NGT) z[i] = (v4u){0u, 0u, 0u, 0u};
      const GAS f32x4* sw = (const GAS f32x4*)a.in[4]; GAS f32x4* so = (GAS f32x4*)(a.out + O_SWIN);
      for (int i = gt; i < SB * (WIN - SS) * (KVW / 4); i += NGT) { const int n = i / ((WIN - SS) * (KVW / 4)), rem = i % ((WIN - SS) * (KVW / 4));
          so[(size_t)n * WIN * (KVW / 4) + rem] = sw[(size_t)n * WIN * (KVW / 4) + SS * (KVW / 4) + rem]; }
    }
    for (int m = gw; m < M; m += NGW) {
        GAS unsigned long long* o8 = (GAS unsigned long long*)((bf16*)(ws + WS_XB) + (size_t)m * D) + F.lane;
        if (m >= MR) {
#pragma unroll
            for (int j = 0; j < 4; ++j) o8[64 * j] = 0ull;
            continue; }
        const float* xrow = m < MP ? (const float*)a.in[0] + (size_t)m * D : (const float*)a.in[1] + (size_t)(m - MP) * D;
        const GAS f32x4* xr = (const GAS f32x4*)xrow + F.lane;
#pragma unroll
        for (int j = 0; j < 4; ++j) { const f32x4 v = xr[64 * j]; o8[64 * j] = (unsigned long long)pk2(v.x, v.y) | ((unsigned long long)pk2(v.z, v.w) << 32); }
    }
}
__device__ __forceinline__ void ln_phase(Frame& F, const float* V, const float* gam, const float* bet, float* of_p, float* of_s, bf16* XB) {
    const int gw = F.vcu * NWAVES + F.wave, NGW = F.G * NWAVES;
    f32x4 g4[4], b4[4];
#pragma unroll
    for (int j = 0; j < 4; ++j) { g4[j] = ((const GAS f32x4*)gam)[F.lane + 64 * j]; b4[j] = ((const GAS f32x4*)bet)[F.lane + 64 * j]; }
    for (int m = gw; m < M; m += NGW) {
        if (m >= MR) { if (XB) { GAS unsigned long long* o8 = (GAS unsigned long long*)(XB + (size_t)m * D) + F.lane;
#pragma unroll
                for (int j = 0; j < 4; ++j) o8[64 * j] = 0ull; }
            continue; }
        const GAS f32x4* xr = (const GAS f32x4*)(V + (size_t)m * D) + F.lane;
        f32x4 v[4]; float s = 0.f;
#pragma unroll
        for (int j = 0; j < 4; ++j) { v[j] = xr[64 * j]; s += (v[j].x + v[j].y) + (v[j].z + v[j].w); }
        const float mean = wave_sum(s) * (1.f / D); float s2 = 0.f;
#pragma unroll
        for (int j = 0; j < 4; ++j) { v[j] = v[j] - mean; s2 += (v[j].x * v[j].x + v[j].y * v[j].y) + (v[j].z * v[j].z + v[j].w * v[j].w); }
        const float rstd = 1.f / sqrtf(wave_sum(s2) * (1.f / D) + LN_EPS);
        float* orow = m < MP ? of_p + (size_t)m * D : of_s + (size_t)(m - MP) * D;
        GAS f32x4* of = (GAS f32x4*)orow + F.lane;
#pragma unroll
        for (int j = 0; j < 4; ++j) { v[j] = v[j] * rstd * g4[j] + b4[j]; of[64 * j] = v[j]; }
        if (XB) { GAS unsigned long long* o8 = (GAS unsigned long long*)(XB + (size_t)m * D) + F.lane;
#pragma unroll
            for (int j = 0; j < 4; ++j) o8[64 * j] = (unsigned long long)pk2(v[j].x, v[j].y) | ((unsigned long long)pk2(v[j].z, v[j].w) << 32); }
    }
}
__device__ __forceinline__ void conv_phase(Frame& F, const KArgs& a) {
    const int gw = F.vcu * NWAVES + F.wave, NGW = F.G * NWAVES;
    const float* U = (const float*)(a.ws + WS_U); const bf16* CB = (const bf16*)(a.ws + WS_CB); bf16* A2 = (bf16*)(a.ws + WS_A2);
    const float* wc = (const float*)a.in[14]; const float* sc = (const float*)a.in[5];
    f32x4 w0[2], w1[2], w2[2];
#pragma unroll
    for (int j = 0; j < 2; ++j) { const int ch = 4 * F.lane + 256 * j; w0[j] = *(const GAS f32x4*)(wc + ch); w1[j] = *(const GAS f32x4*)(wc + DC + ch); w2[j] = *(const GAS f32x4*)(wc + 2 * DC + ch); }
    for (int m = gw; m < MR; m += NGW) {
#pragma unroll
        for (int j = 0; j < 2; ++j) {
            const int ch = 4 * F.lane + 256 * j;
            const f32x4 uc = *(const GAS f32x4*)(U + (size_t)m * DC + ch);
            f32x4 u1, u2;
            if (m < MP) { const int t = m & (T - 1);
                u1 = t >= 1 ? *(const GAS f32x4*)(U + (size_t)(m - 1) * DC + ch) : (f32x4){0.f, 0.f, 0.f, 0.f};
                u2 = t >= 2 ? *(const GAS f32x4*)(U + (size_t)(m - 2) * DC + ch) : (f32x4){0.f, 0.f, 0.f, 0.f};
            } else { const int si = m - MP, n = si >> 2, s = si & 3;
                u1 = s >= 1 ? *(const GAS f32x4*)(U + (size_t)(m - 1) * DC + ch) : *(const GAS f32x4*)(sc + (size_t)(n * 2 + 1) * DC + ch);
                u2 = s >= 2 ? *(const GAS f32x4*)(U + (size_t)(m - 2) * DC + ch) : *(const GAS f32x4*)(sc + (size_t)(n * 2 + s) * DC + ch);
            }
            const unsigned long long cbw = *(const GAS unsigned long long*)(CB + (size_t)m * DC + ch);
            f32x4 cb; cb.x = __uint_as_float((unsigned)(cbw & 0xffffu) << 16); cb.y = __uint_as_float((unsigned)((cbw >> 16) & 0xffffu) << 16);
            cb.z = __uint_as_float((unsigned)((cbw >> 32) & 0xffffu) << 16); cb.w = __uint_as_float((unsigned)((cbw >> 48) & 0xffffu) << 16);
            const f32x4 y = cb * (w0[j] * u2 + w1[j] * u1 + w2[j] * uc);
            *(GAS unsigned long long*)(A2 + (size_t)m * D + DA + ch) = (unsigned long long)pk2(y.x, y.y) | ((unsigned long long)pk2(y.z, y.w) << 32);
        }
    }
}
constexpr int CMP_NBLKS = NB * NBP + SB * NBS, CMP_UB = 34, CMP_UNITS = CMP_NBLKS / CMP_UB;
static_assert(CMP_UNITS * CMP_UB == CMP_NBLKS, "compress units");
constexpr int CL_PTR = 0, CL_A = 1024, CL_ABYTES = CMP_UB * 512, CL_HID = 36864;
static_assert(CL_A + 2 * CL_ABYTES <= CL_HID, "compress LDS map");
__device__ __forceinline__ void compress_phase(Frame& F, const KArgs& a) {
    typedef short bf16x8v __attribute__((ext_vector_type(8)));
    const int tid = F.tid, lane = F.lane, wid = F.wave;
    const float* pe = (const float*)a.in[17]; const float* w2 = (const float*)a.in[16];
    const bf16* W1T = (const bf16*)(a.ws + WS_W1T); float* KC = (float*)(a.ws + WS_KC);
    const int* pt = (const int*)a.in[6]; const float* pool = (const float*)a.in[2];
    LAS unsigned long long* ptrs = (LAS unsigned long long*)(F.lds + CL_PTR);
    LAS float* hid = (LAS float*)(F.lds + CL_HID);
    const int c_w = wid >> 2, hq = wid & 3;
    for (int unit = F.vcu; unit < CMP_UNITS; unit += F.G) {
        const int blk0 = unit * CMP_UB;
        __syncthreads();
        if (tid < CMP_UB) { const int id = blk0 + tid; const float* src;
            if (id < NB * NBP) { const int n = id >> 5, b = id & 31; src = a.out + O_PCMP + (size_t)(n * T + b * BLK) * KVW; }
            else { const int sid = id - NB * NBP, n = sid >> 8, b = sid & 255; const int page = pt[n * NPAGES + (b >> 1)]; src = pool + ((size_t)page * PAGE + (size_t)(b & 1) * BLK) * KVW; }
            ptrs[tid] = (unsigned long long)(uintptr_t)src; }
        __syncthreads();
        const float* sp[5]; int e4[5]; bool ok[5];
#pragma unroll
        for (int k = 0; k < 5; ++k) { const int f = tid + 512 * k; ok[k] = f < CMP_UB * 64; const int b = ok[k] ? (f >> 6) : 0; e4[k] = f & 63; sp[k] = (const float*)(uintptr_t)ptrs[b] + e4[k] * 4; }
        f32x4 st[5]; bf16x8v bw[2];
#pragma unroll
        for (int k = 0; k < 5; ++k) if (ok[k]) st[k] = *(const GAS f32x4*)(sp[k]);
        const bf16* wrow = W1T + ((size_t)c_w * 64 + hq * 16 + (lane & 15)) * 4096 + 8 * (lane >> 4);
        bw[0] = *(const GAS bf16x8v*)(wrow); bw[1] = *(const GAS bf16x8v*)(wrow + 32);
        f32x4 acc[5];
#pragma unroll
        for (int mt = 0; mt < 5; ++mt) acc[mt] = (f32x4){0.f, 0.f, 0.f, 0.f};
        for (int p = 0; p < BLK; ++p) {
            LAS unsigned char* abuf = F.lds + CL_A + (p & 1) * CL_ABYTES;
#pragma unroll
            for (int k = 0; k < 5; ++k) if (ok[k]) { const int f = tid + 512 * k; const f32x4 pv = *(const GAS f32x4*)(pe + p * 128 + (e4[k] >> 5) * 64 + (e4[k] & 15) * 4); const f32x4 v = st[k] + pv;
                *(LAS unsigned long long*)(abuf + (f >> 6) * 512 + e4[k] * 8) = (unsigned long long)pk2(v.x, v.y) | ((unsigned long long)pk2(v.z, v.w) << 32); }
            const bf16x8v b0 = bw[0], b1 = bw[1];
            if (p + 1 < BLK) {
#pragma unroll
                for (int k = 0; k < 5; ++k) if (ok[k]) st[k] = *(const GAS f32x4*)(sp[k] + (size_t)(p + 1) * KVW);
                bw[0] = *(const GAS bf16x8v*)(wrow + (p + 1) * 64); bw[1] = *(const GAS bf16x8v*)(wrow + (p + 1) * 64 + 32);
            }
            __syncthreads();
#pragma unroll
            for (int mt = 0; mt < 5; ++mt) { int row = mt * 16 + (lane & 15); if (row >= 2 * CMP_UB) row = 2 * CMP_UB - 1;
                const LAS unsigned char* ap = abuf + (row >> 1) * 512 + (c_w * 128 + (row & 1) * 64 + 8 * (lane >> 4)) * 2;
                const bf16x8v a0 = *(const LAS bf16x8v*)(ap), a1 = *(const LAS bf16x8v*)(ap + 64);
                acc[mt] = __builtin_amdgcn_mfma_f32_16x16x32_bf16(a0, b0, acc[mt], 0, 0, 0);
                acc[mt] = __builtin_amdgcn_mfma_f32_16x16x32_bf16(a1, b1, acc[mt], 0, 0, 0); }
        }
#pragma unroll
        for (int mt = 0; mt < 5; ++mt)
#pragma unroll
            for (int i = 0; i < 4; ++i) { const int row = mt * 16 + (lane >> 4) * 4 + i; const float x = acc[mt][i];
                hid[(c_w * 80 + row) * 64 + hq * 16 + (lane & 15)] = x * __builtin_amdgcn_rcpf(1.0f + __builtin_amdgcn_exp2f(-1.4426950408889634f * x)); }
        __syncthreads();
        for (int pr = wid; pr < 2 * 2 * CMP_UB; pr += NWAVES) { const int c = pr / (2 * CMP_UB), row = pr % (2 * CMP_UB);
            const LAS float* hr = hid + (c * 80 + row) * 64; const float* wp = w2 + (size_t)c * 64 * 64 + lane; float s = 0.f;
#pragma unroll 16
            for (int h = 0; h < 64; ++h) s += hr[h] * wp[h * 64];
            KC[(size_t)(blk0 + (row >> 1)) * 256 + c * 128 + (row & 1) * 64 + lane] = s; }
    }
}
__device__ __forceinline__ float bf2f(unsigned short x) { return __uint_as_float((unsigned)x << 16); }
__device__ __forceinline__ int wave_min_i(int v) {
#pragma unroll
    for (int o = 1; o < 64; o <<= 1) { const int t = __shfl_xor(v, o); v = t < v ? t : v; }
    return v;
}
template <bool F32> __device__ __forceinline__ void dot4h(const void* krow, const LAS float* qf, float (&s)[4]) {
    s[0] = s[1] = s[2] = s[3] = 0.f;
    if (F32) {
#pragma unroll
        for (int d4 = 0; d4 < 16; ++d4) { const f32x4 k = ((const GAS f32x4*)krow)[d4];
#pragma unroll
            for (int h = 0; h < 4; ++h) { const f32x4 q = ((const LAS f32x4*)qf)[h * 16 + d4]; s[h] += (k.x * q.x + k.y * q.y) + (k.z * q.z + k.w * q.w); } }
    } else {
#pragma unroll
        for (int d8 = 0; d8 < 8; ++d8) { const v4u kk = ((const GAS v4u*)krow)[d8];
            const f32x4 k0 = {__uint_as_float(kk.x << 16), __uint_as_float(kk.x & 0xffff0000u), __uint_as_float(kk.y << 16), __uint_as_float(kk.y & 0xffff0000u)};
            const f32x4 k1 = {__uint_as_float(kk.z << 16), __uint_as_float(kk.z & 0xffff0000u), __uint_as_float(kk.w << 16), __uint_as_float(kk.w & 0xffff0000u)};
#pragma unroll
            for (int h = 0; h < 4; ++h) { const f32x4 q0 = ((const LAS f32x4*)qf)[h * 16 + 2 * d8], q1 = ((const LAS f32x4*)qf)[h * 16 + 2 * d8 + 1];
                s[h] += ((k0.x * q0.x + k0.y * q0.y) + (k0.z * q0.z + k0.w * q0.w)) + ((k1.x * q1.x + k1.y * q1.y) + (k1.z * q1.z + k1.w * q1.w)); } }
    }
}
__device__ __forceinline__ void osm_update(const float (&s)[4], bool valid, float (&m)[4], float (&l)[4], float (&o)[4], LAS float* pb, int lane) {
#pragma unroll
    for (int h = 0; h < 4; ++h) {
        const float mb = wave_max(valid ? s[h] : -INFINITY);
        const float mn = fmaxf(m[h], mb);
        const float al = (m[h] == -INFINITY) ? 0.f : __builtin_amdgcn_exp2f(m[h] - mn);
        const float p = valid ? __builtin_amdgcn_exp2f(s[h] - mn) : 0.f;
        l[h] = l[h] * al + wave_sum(p); o[h] *= al; m[h] = mn; pb[h * 64 + lane] = p;
    }
}
template <bool SAMPLE> __device__ __forceinline__ void attn_task(Frame& F, const KArgs& a, int n, int g, int tq) {
    const int lane = F.lane;
    LAS float* wl = (LAS float*)(F.lds + F.wave * 16384);
    LAS float* qf = wl; LAS float* pb = wl + 256; LAS int* sl = (LAS int*)(wl + 256 + 1024);
    const int row = SAMPLE ? MP + n * SS + tq : n * T + tq;
    const int qpos = SAMPLE ? PAST + tq : tq;
    const unsigned char* ws = a.ws;
    const bf16* Q = (const bf16*)(ws + WS_Q); const bf16* KS = (const bf16*)(ws + WS_KS); const bf16* KW = (const bf16*)(ws + WS_KW);
    LDS_WAIT(); asm volatile("" ::: "memory");
#pragma unroll
    for (int h = 0; h < 4; ++h) qf[h * 64 + lane] = bf2f(Q[(size_t)row * DA + (g * 4 + h) * 64 + lane]);
    LDS_WAIT(); asm volatile("" ::: "memory");
    constexpr int NBLK = SAMPLE ? NBS : NBP, NC = SAMPLE ? 4 : 1;
    const float* KC = (const float*)(ws + WS_KC) + (size_t)(SAMPLE ? (NB * NBP + n * NBS) : n * NBP) * 256;
    float imp[NC]; float ocmp[4] = {0.f, 0.f, 0.f, 0.f};
    {
#pragma unroll 1
        for (int jj = 0; jj < NC; ++jj) { const int j = lane + 64 * jj; const bool vis = (j < NBLK) && ((j + 1) * BLK - 1 <= qpos);
            if (j < NBLK) { float s4[4]; dot4h<true>(KC + (size_t)j * 256 + g * 64, qf, s4);
#pragma unroll
                for (int h = 0; h < 4; ++h) pb[h * 256 + j] = vis ? s4[h] : -INFINITY; } }
        LDS_WAIT(); asm volatile("" ::: "memory");
#pragma unroll
        for (int jj = 0; jj < NC; ++jj) imp[jj] = 0.f;
#pragma unroll
        for (int h = 0; h < 4; ++h) {
            float sv[NC]; float mx = -INFINITY;
#pragma unroll
            for (int jj = 0; jj < NC; ++jj) { sv[jj] = (lane + 64 * jj < NBLK) ? pb[h * 256 + lane + 64 * jj] : -INFINITY; mx = fmaxf(mx, sv[jj]); }
            mx = wave_max(mx);
            float e[NC], sum = 0.f;
#pragma unroll
            for (int jj = 0; jj < NC; ++jj) { e[jj] = (sv[jj] > -INFINITY) ? __builtin_amdgcn_exp2f(sv[jj] - mx) : 0.f; sum += e[jj]; }
            sum = wave_sum(sum); const float inv = sum > 0.f ? 1.0f / sum : 0.f;
#pragma unroll
            for (int jj = 0; jj < NC; ++jj) { const float p = e[jj] * inv; imp[jj] += p; if (lane + 64 * jj < NBLK) pb[h * 256 + lane + 64 * jj] = p; }
        }
        LDS_WAIT(); asm volatile("" ::: "memory");
        int nvis = (qpos + 1) / BLK; if (nvis > NBLK) nvis = NBLK;
        for (int j = 0; j < nvis; ++j) { const float v = KC[(size_t)j * 256 + 128 + g * 64 + lane];
#pragma unroll
            for (int h = 0; h < 4; ++h) ocmp[h] += pb[h * 256 + j] * v; }
        LDS_WAIT(); asm volatile("" ::: "memory");
    }
    const int cur = qpos >> 6;
    {
        float cand[NC];
#pragma unroll
        for (int jj = 0; jj < NC; ++jj) { const int j = lane + 64 * jj;
            cand[jj] = (j >= NBLK) ? -INFINITY : (j > cur) ? -1e30f : (j == 0 || j == cur || j == cur - 1) ? 1e4f : imp[jj]; }
        constexpr int NIT = SAMPLE ? NSEL - 1 : NSEL;
        for (int it = 0; it < NIT; ++it) {
            float lm = cand[0];
#pragma unroll
            for (int jj = 1; jj < NC; ++jj) lm = fmaxf(lm, cand[jj]);
            const float mx = wave_max(lm);
            int lj = 0x7fffffff;
#pragma unroll
            for (int jj = NC - 1; jj >= 0; --jj) if (cand[jj] == mx) lj = lane + 64 * jj;
            const int sj = wave_min_i(lj);
            if (lane == 0) sl[it] = sj;
#pragma unroll
            for (int jj = 0; jj < NC; ++jj) if (lane + 64 * jj == sj) cand[jj] = -INFINITY;
        }
        if (SAMPLE) { if (lane == 0) sl[NSEL - 1] = NBS; }
        LDS_WAIT(); asm volatile("" ::: "memory");
    }
    float osel[4] = {0.f, 0.f, 0.f, 0.f};
    {
        float m[4] = {-INFINITY, -INFINITY, -INFINITY, -INFINITY}, l[4] = {0.f, 0.f, 0.f, 0.f};
        for (int i = 0; i < NSEL; ++i) {
            const int j = __builtin_amdgcn_readfirstlane(sl[i]);
            if (j > cur) continue;
            const int kpos = j * BLK + lane; const bool valid = kpos <= qpos;
            float s[4];
            if (!SAMPLE) {
                const bf16* kb = KS + (size_t)(n * T + j * BLK) * KVW + g * 64;
                dot4h<false>(kb + (size_t)lane * KVW, qf, s);
                osm_update(s, valid, m, l, osel, pb, lane);
                LDS_WAIT(); asm volatile("" ::: "memory");
                for (int k = 0; k < BLK; ++k) { const float v = bf2f(kb[(size_t)k * KVW + 128 + lane]);
#pragma unroll
                    for (int h = 0; h < 4; ++h) osel[h] += pb[h * 64 + k] * v; }
            } else {
                const float* kb; int nk = BLK;
                if (j < NBS) { const int page = ((const int*)a.in[6])[n * NPAGES + (j >> 1)]; kb = (const float*)a.in[3] + ((size_t)page * PAGE + (size_t)(j & 1) * BLK) * KVW + g * 64; }
                else { kb = a.out + O_SSEL + (size_t)(n * SS) * KVW + g * 64; nk = SS; }
                const int kl = lane < nk ? lane : nk - 1;
                dot4h<true>(kb + (size_t)kl * KVW, qf, s);
                osm_update(s, valid && lane < nk, m, l, osel, pb, lane);
                LDS_WAIT(); asm volatile("" ::: "memory");
                for (int k = 0; k < nk; ++k) { const float v = kb[(size_t)k * KVW + 128 + lane];
#pragma unroll
                    for (int h = 0; h < 4; ++h) osel[h] += pb[h * 64 + k] * v; }
            }
            LDS_WAIT(); asm volatile("" ::: "memory");
        }
#pragma unroll
        for (int h = 0; h < 4; ++h) osel[h] = l[h] > 0.f ? osel[h] / l[h] : 0.f;
    }
    float owin[4] = {0.f, 0.f, 0.f, 0.f};
    {
        float m[4] = {-INFINITY, -INFINITY, -INFINITY, -INFINITY}, l[4] = {0.f, 0.f, 0.f, 0.f};
        for (int c = 0; c < WIN / 64; ++c) {
            float s[4];
            if (!SAMPLE) {
                const int k0 = qpos - (WIN - 1) + 64 * c; if (k0 + 63 < 0) continue;
                const int kpos = k0 + lane; const bool valid = kpos >= 0; const int kc = valid ? kpos : 0;
                dot4h<false>(KW + (size_t)(n * T + kc) * KVW + g * 64, qf, s);
                osm_update(s, valid, m, l, owin, pb, lane);
                LDS_WAIT(); asm volatile("" ::: "memory");
                for (int k = 0; k < 64; ++k) { const int kp = k0 + k; if (kp < 0) continue; const float v = bf2f(KW[(size_t)(n * T + kp) * KVW + 128 + g * 64 + lane]);
#pragma unroll
                    for (int h = 0; h < 4; ++h) owin[h] += pb[h * 64 + k] * v; }
            } else {
                const int i0 = tq + 1 + 64 * c;
                const float* st = (const float*)a.in[4] + (size_t)n * WIN * KVW; const float* nw = a.out + O_SWIN + (size_t)(n * WIN + (WIN - SS)) * KVW;
                const int i = i0 + lane; const float* kr = (i < WIN ? st + (size_t)i * KVW : nw + (size_t)(i - WIN) * KVW) + g * 64;
                dot4h<true>(kr, qf, s);
                osm_update(s, true, m, l, owin, pb, lane);
                LDS_WAIT(); asm volatile("" ::: "memory");
                for (int k = 0; k < 64; ++k) { const int ik = i0 + k; const float v = (ik < WIN ? st + (size_t)ik * KVW : nw + (size_t)(ik - WIN) * KVW)[128 + g * 64 + lane];
#pragma unroll
                    for (int h = 0; h < 4; ++h) owin[h] += pb[h * 64 + k] * v; }
            }
            LDS_WAIT(); asm volatile("" ::: "memory");
        }
#pragma unroll
        for (int h = 0; h < 4; ++h) owin[h] = l[h] > 0.f ? owin[h] / l[h] : 0.f;
    }
    const float* G = (const float*)(ws + WS_G) + (size_t)row * 32; bf16* A2 = (bf16*)(ws + WS_A2);
#pragma unroll
    for (int h = 0; h < 4; ++h) { const int hh = g * 4 + h; const float o = G[hh] * ocmp[h] + G[8 + hh] * osel[h] + G[16 + hh] * owin[h];
        A2[(size_t)row * D + hh * 64 + lane] = (bf16)f2bf(o); }
}
__device__ __forceinline__ void attn_phase(Frame& F, const KArgs& a) {
    { const int gt = F.vcu * (NWAVES * 64) + F.tid, NGT = F.G * NWAVES * 64; bf16* A2 = (bf16*)(a.ws + WS_A2);
      for (int i = gt; i < (M - MR) * (D / 8); i += NGT) *(GAS v4u*)(A2 + (size_t)MR * D + (size_t)i * 8) = (v4u){0u, 0u, 0u, 0u}; }
#ifndef NO_SAMPLE
    for (int task = F.vcu + F.G * F.wave; task < SB * NKV * SS; task += F.G * NWAVES) { const int n = task >> 3, g = (task >> 2) & 1, s = task & 3; attn_task<true>(F, a, n, g, s); }
#endif
#ifndef NO_PROMPT
    const int per = (NB * NKV * T + F.G - 1) / F.G;
    for (int i = F.wave; i < per; i += NWAVES) { const int task = F.vcu * per + i; if (task >= NB * NKV * T) break;
        const int n = task >> 12, g = (task >> 11) & 1, t = task & (T - 1); attn_task<false>(F, a, n, g, t); }
#endif
}
namespace pattn {
typedef short bf16x8 __attribute__((ext_vector_type(8)));
typedef short s16x4 __attribute__((ext_vector_type(4)));
typedef float f32x16 __attribute__((ext_vector_type(16)));
constexpr int L_KV = 32768, SLOT = 16384;
constexpr int L_KC = 65536;
constexpr int L_IMP = 0;
constexpr int L_SELM = 73728, L_UNI = L_SELM + 256;
__device__ __forceinline__ int crow(int r, int hi) { return (r & 3) + 8 * (r >> 2) + 4 * hi; }
__device__ __forceinline__ unsigned cvtpk(float lo, float hi) { typedef float f2 __attribute__((ext_vector_type(2))); typedef __bf16 b2 __attribute__((ext_vector_type(2))); f2 v = {lo, hi}; b2 b = __builtin_convertvector(v, b2); return __builtin_bit_cast(unsigned, b); }
__device__ __forceinline__ float swapmax(float v) { auto rr = __builtin_amdgcn_permlane32_swap(__float_as_uint(v), __float_as_uint(v), false, false); return fmaxf(__uint_as_float(rr[0]), __uint_as_float(rr[1])); }
__device__ __forceinline__ float swapsum(float v) { auto rr = __builtin_amdgcn_permlane32_swap(__float_as_uint(v), __float_as_uint(v), false, false); return __uint_as_float(rr[0]) + __uint_as_float(rr[1]); }
typedef short v4i16_t __attribute__((ext_vector_type(4)));
__device__ __forceinline__ s16x4 vtr(const LAS unsigned char* p) { return __builtin_bit_cast(s16x4, __builtin_amdgcn_ds_read_tr16_b64_v4i16((LAS v4i16_t*)p)); }
__device__ __forceinline__ bf16x8 vfrag(const LAS unsigned char* p) { const s16x4 lo = vtr(p), hi = vtr(p + 512); return (bf16x8){lo[0], lo[1], lo[2], lo[3], hi[0], hi[1], hi[2], hi[3]}; }
#define PK8(P, B) __builtin_bit_cast(bf16x8, (v4u){cvtpk(P[B], P[B + 1]), cvtpk(P[B + 2], P[B + 3]), cvtpk(P[B + 4], P[B + 5]), cvtpk(P[B + 6], P[B + 7])})

template <int MODE> __device__ __forceinline__ void block_step(const LAS unsigned char* sb, const bf16x8 (&qr)[4], int j, int c, int tl, unsigned mymask, int r32, int hh, int voff,
                                                               float& m, float& l, f32x16 (&o)[2]) {
    f32x16 p0 = {}, p1 = {};
#pragma unroll
    for (int d0 = 0; d0 < 4; ++d0) { const LAS unsigned char* kb = sb + (2 * d0 + hh) * 1024 + r32 * 16;
        const bf16x8 b0 = *(const LAS bf16x8*)kb, b1 = *(const LAS bf16x8*)(kb + 512);
        p0 = __builtin_amdgcn_mfma_f32_32x32x16_bf16(b0, qr[d0], p0, 0, 0, 0); p1 = __builtin_amdgcn_mfma_f32_32x32x16_bf16(b1, qr[d0], p1, 0, 0, 0); }
    __builtin_amdgcn_sched_barrier(0);
    int tlo = tl; asm volatile("" : "+v"(tlo));
    if (MODE == 0) { if (!((mymask >> j) & 1u)) {
#pragma unroll
            for (int r = 0; r < 16; ++r) { p0[r] = -INFINITY; p1[r] = -INFINITY; } } }
    if (j == c) {
#pragma unroll
        for (int r = 0; r < 16; ++r) { const int kl = crow(r, hh); if (kl > tlo) p0[r] = -INFINITY; if (kl + 32 > tlo) p1[r] = -INFINITY; } }
    if (MODE == 1) { if (j == c - 8) {
#pragma unroll
            for (int r = 0; r < 16; ++r) { const int kl = crow(r, hh); if (kl <= tlo) p0[r] = -INFINITY; if (kl + 32 <= tlo) p1[r] = -INFINITY; } } }
    float mx = fmaxf(p0[0], p1[0]);
#pragma unroll
    for (int r = 1; r < 16; ++r) mx = fmaxf(mx, fmaxf(p0[r], p1[r]));
    mx = swapmax(mx);
    const float mn = fmaxf(m, mx), al = __builtin_amdgcn_exp2f(m - mn); m = mn;
    float s = 0.f;
#pragma unroll
    for (int r = 0; r < 16; ++r) { p0[r] = __builtin_amdgcn_exp2f(p0[r] - mn); p1[r] = __builtin_amdgcn_exp2f(p1[r] - mn); s += p0[r] + p1[r]; }
    l = l * al + s;
#pragma unroll
    for (int r = 0; r < 16; ++r) { o[0][r] *= al; o[1][r] *= al; }
    const bf16x8 pw0 = PK8(p0, 0), pw1 = PK8(p0, 8), pw2 = PK8(p1, 0), pw3 = PK8(p1, 8);
    const LAS unsigned char* vb = sb + 8192 + voff;
    __builtin_amdgcn_sched_barrier(0);
#pragma unroll
    for (int d0 = 0; d0 < 2; ++d0) {
        if (d0 == 1) __builtin_amdgcn_sched_barrier(0);
        o[d0] = __builtin_amdgcn_mfma_f32_32x32x16_bf16(vfrag(vb + (d0 * 4 + 0) * 1024), pw0, o[d0], 0, 0, 0);
        o[d0] = __builtin_amdgcn_mfma_f32_32x32x16_bf16(vfrag(vb + (d0 * 4 + 1) * 1024), pw1, o[d0], 0, 0, 0);
        __builtin_amdgcn_sched_barrier(0);
        o[d0] = __builtin_amdgcn_mfma_f32_32x32x16_bf16(vfrag(vb + (d0 * 4 + 2) * 1024), pw2, o[d0], 0, 0, 0);
        o[d0] = __builtin_amdgcn_mfma_f32_32x32x16_bf16(vfrag(vb + (d0 * 4 + 3) * 1024), pw3, o[d0], 0, 0, 0);
    }
}
template <int MODE> __device__ __forceinline__ void run_branch(LAS unsigned char* lds, const bf16* src, int n, int g, unsigned blocks, const bf16x8 (&qr)[4], int c, int tl, unsigned mymask,
                                                               int tid, int r32, int hh, int voff, float gate, f32x16 (&ofin)[2]) {
    const int lane = tid & 63, wid = tid >> 6;
    float m = -1e30f, l = 0.f; f32x16 o[2] = {};
    const bf16* kg = src + (size_t)(n * T + lane) * KVW + g * 64 + wid * 8;
    const bf16* vg = src + (size_t)(n * T + 16 * (wid & 3) + (lane >> 2)) * KVW + 128 + g * 64 + (wid >> 2) * 32 + (lane & 3) * 8;
    const int kdst = wid * 1024 + lane * 16, vdst = 8192 + wid * 1024 + lane * 16;
    unsigned rem = blocks; int j = __builtin_ctz(rem); rem &= rem - 1;
    v4u kreg = *(const GAS v4u*)(kg + (size_t)j * BLK * KVW), vreg = *(const GAS v4u*)(vg + (size_t)j * BLK * KVW);
    int slot = 0;
    for (;;) {
        LAS unsigned char* sb = lds + L_KV + slot * SLOT;
        *(LAS v4u*)(sb + kdst) = kreg; *(LAS v4u*)(sb + vdst) = vreg;
        const int jn = rem ? __builtin_ctz(rem) : -1;
        if (jn >= 0) { kreg = *(const GAS v4u*)(kg + (size_t)jn * BLK * KVW); vreg = *(const GAS v4u*)(vg + (size_t)jn * BLK * KVW); }
        __syncthreads();
        block_step<MODE>(sb, qr, j, c, tl, mymask, r32, hh, voff, m, l, o);
        if (jn < 0) break;
        j = jn; rem &= rem - 1; slot ^= 1;
    }
    l = swapsum(l);
    const float sc = l > 0.f ? gate / l : 0.f;
#pragma unroll
    for (int r = 0; r < 16; ++r) { ofin[0][r] += sc * o[0][r]; ofin[1][r] += sc * o[1][r]; }
}
__device__ __forceinline__ void unit(Frame& F, const KArgs& a, int n, int g, int c) {
    LAS unsigned char* lds = F.lds;
    int tid = F.tid; asm volatile("" : "+v"(tid));
    const int lane = tid & 63, wid = F.wave, r32 = lane & 31, hh = lane >> 5, hl = wid >> 1, qsub = wid & 1, tl = 32 * qsub + r32;
    const int h = g * 4 + hl, row = n * T + 64 * c + tl;
    const unsigned char* ws = a.ws;
    const bf16* Q = (const bf16*)(ws + WS_Q); const float* KC = (const float*)(ws + WS_KC) + (size_t)(n * NBP) * 256; const float* G = (const float*)(ws + WS_G) + (size_t)row * 32;
    const int voff = ((lane >> 4) & 1) * 32 + (lane & 3) * 8 + (4 * hh + ((lane & 15) >> 2)) * 64;
    __syncthreads();
    { const int j = tid >> 4, d = (tid & 15) * 4;
      const f32x4 kc = *(const GAS f32x4*)(KC + (size_t)j * 256 + g * 64 + d), vc = *(const GAS f32x4*)(KC + (size_t)j * 256 + 128 + g * 64 + d);
      *(LAS unsigned long long*)(lds + L_KC + (d >> 3) * 512 + j * 16 + (d & 7) * 2) = (unsigned long long)pk2(kc.x, kc.y) | ((unsigned long long)pk2(kc.z, kc.w) << 32);
      *(LAS unsigned long long*)(lds + L_KC + 4096 + ((d >> 5) * 2 + (j >> 4)) * 1024 + (j & 15) * 64 + (d & 31) * 2) = (unsigned long long)pk2(vc.x, vc.y) | ((unsigned long long)pk2(vc.z, vc.w) << 32);
      if (tid < 65) ((LAS unsigned*)(lds + L_SELM))[tid] = 0u; }
    bf16x8 qr[4];
#pragma unroll
    for (int d0 = 0; d0 < 4; ++d0) qr[d0] = *(const GAS bf16x8*)(Q + (size_t)row * DA + h * 64 + d0 * 16 + hh * 8);
    const float g_cmp = G[h], g_sel = G[8 + h], g_win = G[16 + h];
    __syncthreads();
    f32x16 ofin[2] = {};
    {
        f32x16 p = {};
#pragma unroll
        for (int d0 = 0; d0 < 4; ++d0) { const bf16x8 kf = *(const LAS bf16x8*)(lds + L_KC + (2 * d0 + hh) * 512 + r32 * 16); p = __builtin_amdgcn_mfma_f32_32x32x16_bf16(kf, qr[d0], p, 0, 0, 0); }
        const int jlim = (tl == 63) ? c : c - 1;
        float mx = -INFINITY;
#pragma unroll
        for (int r = 0; r < 16; ++r) { if (crow(r, hh) > jlim) p[r] = -INFINITY; mx = fmaxf(mx, p[r]); }
        mx = swapmax(mx);
        const float mref = mx > -INFINITY ? mx : 0.f; float s = 0.f;
#pragma unroll
        for (int r = 0; r < 16; ++r) { p[r] = __builtin_amdgcn_exp2f(p[r] - mref); s += p[r]; }
        s = swapsum(s); const float inv = s > 0.f ? 1.0f / s : 0.f;
        LAS float* imp = (LAS float*)(lds + L_IMP);
#pragma unroll
        for (int r = 0; r < 16; ++r) { p[r] *= inv; imp[(hl * 32 + crow(r, hh)) * 64 + tl] = p[r]; }
        const bf16x8 pc0 = PK8(p, 0), pc1 = PK8(p, 8);
        f32x16 oc[2] = {};
        const LAS unsigned char* vb = lds + L_KC + 4096 + voff;
#pragma unroll
        for (int d0 = 0; d0 < 2; ++d0) { oc[d0] = __builtin_amdgcn_mfma_f32_32x32x16_bf16(vfrag(vb + (d0 * 2 + 0) * 1024), pc0, oc[d0], 0, 0, 0);
                                         oc[d0] = __builtin_amdgcn_mfma_f32_32x32x16_bf16(vfrag(vb + (d0 * 2 + 1) * 1024), pc1, oc[d0], 0, 0, 0); }
#pragma unroll
        for (int r = 0; r < 16; ++r) { ofin[0][r] = g_cmp * oc[0][r]; ofin[1][r] = g_cmp * oc[1][r]; }
    }
    __syncthreads();
    {
        const LAS float* imp = (const LAS float*)(lds + L_IMP);
        const unsigned negm = (c == 31) ? 0u : ~((2u << c) - 1u), forcem = 1u | (1u << c) | (c >= 1 ? (1u << (c - 1)) : 0u);
        float sc[32];
#pragma unroll
        for (int j = 0; j < 32; ++j) { const float v = (imp[(0 * 32 + j) * 64 + lane] + imp[(1 * 32 + j) * 64 + lane]) + (imp[(2 * 32 + j) * 64 + lane] + imp[(3 * 32 + j) * 64 + lane]);
            sc[j] = ((negm >> j) & 1u) ? -1e30f : ((forcem >> j) & 1u) ? 1e4f : v; }
        unsigned bits = 0u;
#pragma unroll
        for (int k = 0; k < 4; ++k) { const int jm = 4 * wid + k;
            const float v = (imp[(0 * 32 + jm) * 64 + lane] + imp[(1 * 32 + jm) * 64 + lane]) + (imp[(2 * 32 + jm) * 64 + lane] + imp[(3 * 32 + jm) * 64 + lane]);
            const float my = ((negm >> jm) & 1u) ? -1e30f : ((forcem >> jm) & 1u) ? 1e4f : v;
            int rank = 0;
#pragma unroll
            for (int j = 0; j < 32; ++j) rank += (sc[j] > my || (sc[j] == my && j < jm)) ? 1 : 0;
            if (rank < NSEL) bits |= 1u << jm; }
        if (bits) { atomicOr((unsigned*)(lds + L_SELM) + lane, bits); atomicOr((unsigned*)(lds + L_UNI), bits); }
    }
    __syncthreads();
    const unsigned mymask = ((const LAS unsigned*)(lds + L_SELM))[tl];
    const unsigned cmask = (c == 31) ? 0xffffffffu : ((2u << c) - 1u);
    const unsigned uni = (unsigned)__builtin_amdgcn_readfirstlane(*(const LAS unsigned*)(lds + L_UNI)) & cmask;
    run_branch<0>(lds, (const bf16*)(ws + WS_KS), n, g, uni, qr, c, tl, mymask, tid, r32, hh, voff, g_sel, ofin);
    __syncthreads();
    const unsigned wmask = cmask & ~((c >= 8) ? ((1u << (c - 8)) - 1u) : 0u);
    run_branch<1>(lds, (const bf16*)(ws + WS_KW), n, g, wmask, qr, c, tl, mymask, tid, r32, hh, voff, g_win, ofin);
    bf16* A2 = (bf16*)(ws + WS_A2) + (size_t)row * D + h * 64;
#pragma unroll
    for (int d0 = 0; d0 < 2; ++d0)
#pragma unroll
        for (int r4 = 0; r4 < 4; ++r4) { const int d = 32 * d0 + 8 * r4 + 4 * hh;
            *(GAS unsigned long long*)(A2 + d) = (unsigned long long)cvtpk(ofin[d0][4 * r4], ofin[d0][4 * r4 + 1]) | ((unsigned long long)cvtpk(ofin[d0][4 * r4 + 2], ofin[d0][4 * r4 + 3]) << 32); }
}
#undef PK8
}
__device__ __forceinline__ void attn_phase2(Frame& F, const KArgs& a) {
    { const int gt = F.vcu * (NWAVES * 64) + F.tid, NGT = F.G * NWAVES * 64; bf16* A2 = (bf16*)(a.ws + WS_A2);
      for (int i = gt; i < (M - MR) * (D / 8); i += NGT) *(GAS v4u*)(A2 + (size_t)MR * D + (size_t)i * 8) = (v4u){0u, 0u, 0u, 0u}; }
    for (int task = F.vcu + F.G * F.wave; task < SB * NKV * SS; task += F.G * NWAVES) { const int n = task >> 3, g = (task >> 2) & 1, s = task & 3; attn_task<true>(F, a, n, g, s); }
    if (F.G == 256) { const int ng = F.vcu >> 3, s = F.vcu & 7;
#pragma unroll 1
        for (int i = 0; i < 4; ++i) { const int c = (i == 0) ? s : (i == 1) ? 15 - s : (i == 2) ? 16 + s : 31 - s; pattn::unit(F, a, ng >> 1, ng & 1, c); } }
    else { for (int u = F.vcu; u < NB * NKV * NBP; u += F.G) pattn::unit(F, a, u >> 6, (u >> 5) & 1, u & 31); }
}
#ifndef ATTN_PLACEHOLDER
#define ATTN_PLACEHOLDER 0
#endif
__global__ void __launch_bounds__(NWAVES * 64, 2) mk_fwd(KArgs args) {
    extern __shared__ __attribute__((aligned(16))) unsigned char lds[];
    Frame F;
    F.lds = (LAS unsigned char*)lds;
    F.MISC = (volatile LAS unsigned*)(F.lds + MISC_OFF);
    F.tid = threadIdx.x; F.lane = F.tid & 63; F.wave = __builtin_amdgcn_readfirstlane(F.tid >> 6);
    F.G = gridDim.x; { const int bx = blockIdx.x; F.vcu = (F.G % 8 == 0) ? (bx % 8) * (F.G / 8) + bx / 8 : bx; }
    unsigned char* ws = args.ws;
    F.ctl = (gu32*)(ws + WS_CTL);
    for (int u = F.tid; u < (LDS_BYTES - LDSCTL_OFF) / 4; u += NWAVES * 64) ((LAS unsigned*)(F.lds + LDSCTL_OFF))[u] = 0u;
    __syncthreads();
    XcdBarrier bar = xcd_barrier_post((unsigned*)(F.ctl + CW_BAR), F.MISC + 8);
    const int lo = args.ph_lo, hi = args.ph_hi;
#define IN(k) (lo <= (k) && (k) < hi)
#define GRID_BAR() xcd_barrier(bar)
    bf16* XB = (bf16*)(ws + WS_XB); bf16* HB = (bf16*)(ws + WS_H); float* V = (float*)(ws + WS_V); float* X1 = (float*)(ws + WS_X1); float* X2 = (float*)(ws + WS_X2);
    bf16* A2 = (bf16*)(ws + WS_A2);
    float* out = args.out;

    if (IN(0)) { p0_prologue(F, args); GRID_BAR(); }
    if (IN(1)) { pg8::Gemm g{XB, (const bf16*)(ws + WS_WGUA), M, NGU, D}; pg8::StaticOrder S; S.init(M, NGU, F.G, (int)blockIdx.x);
        pg8::EpiSwiGLU E{HB}; pg8::gemm_phase<pg8::EpiSwiGLU, pg8::StaticOrder, true, true>(F.lds + RING_OFF, g, S, E); GRID_BAR(); }
    if (IN(2)) { pg8::Gemm g{HB, (const bf16*)(ws + WS_WDA), M, D, FF}; pg8::StaticOrder S; S.init(M, D, F.G, (int)blockIdx.x);
        pg8::EpiResPre E{(const float*)args.in[0], (const float*)args.in[1], V, ALPHA, 0.5f}; pg8::gemm_phase<pg8::EpiResPre, pg8::StaticOrder, true, true>(F.lds + RING_OFF, g, S, E); GRID_BAR(); }
    if (IN(3)) { ln_phase(F, V, (const float*)args.in[10], (const float*)args.in[11], X1, X1 + (size_t)MP * D, XB); GRID_BAR(); }
    if (IN(4)) { pg8::Gemm g{XB, (const bf16*)(ws + WS_WIN), M, NINP, D}; pg8::StaticOrder S; S.init(M, NINP, F.G, (int)blockIdx.x);
        pg8::EpiInProj E{(const float*)(ws + WS_BIASP), (bf16*)(ws + WS_CB), (float*)(ws + WS_U), (bf16*)(ws + WS_Q), (bf16*)(ws + WS_KS), (bf16*)(ws + WS_KW), (float*)(ws + WS_G), out};
        pg8::gemm_phase<pg8::EpiInProj, pg8::StaticOrder, true, true>(F.lds + RING_OFF, g, S, E); GRID_BAR(); }
    if (IN(5)) {
        conv_phase(F, args);
#if !ATTN_PLACEHOLDER
#ifndef NO_COMPRESS
        compress_phase(F, args);
#endif
#endif
        GRID_BAR(); }
    if (IN(6)) {
#if ATTN_PLACEHOLDER
        { const int gt = F.vcu * (NWAVES * 64) + F.tid, NGT = F.G * NWAVES * 64;
          for (int i = gt; i < M * (DA / 8); i += NGT) { const int m = i / (DA / 8), c = i % (DA / 8); *(GAS v4u*)(A2 + (size_t)m * D + c * 8) = (v4u){0u, 0u, 0u, 0u}; }
          for (int i = gt; i < (M - MR) * (DC / 8); i += NGT) { const int m = MR + i / (DC / 8), c = i % (DC / 8); *(GAS v4u*)(A2 + (size_t)m * D + DA + c * 8) = (v4u){0u, 0u, 0u, 0u}; } }
#else
#ifndef NO_ATTN
        attn_phase2(F, args);
#endif
#endif
        GRID_BAR(); }
    if (IN(7)) { pg8::Gemm g{A2, (const bf16*)(ws + WS_WOUT), M, D, D}; pg8::StaticOrder S; S.init(M, D, F.G, (int)blockIdx.x);
        pg8::EpiResPre E{X1, X1 + (size_t)MP * D, V, ALPHA, 1.0f}; pg8::gemm_phase<pg8::EpiResPre, pg8::StaticOrder, true, true>(F.lds + RING_OFF, g, S, E); GRID_BAR(); }
    if (IN(8)) { ln_phase(F, V, (const float*)args.in[19], (const float*)args.in[20], X2, X2 + (size_t)MP * D, XB); GRID_BAR(); }
    if (IN(9)) { pg8::Gemm g{XB, (const bf16*)(ws + WS_WGUB), M, NGU, D}; pg8::StaticOrder S; S.init(M, NGU, F.G, (int)blockIdx.x);
        pg8::EpiSwiGLU E{HB}; pg8::gemm_phase<pg8::EpiSwiGLU, pg8::StaticOrder, true, true>(F.lds + RING_OFF, g, S, E); GRID_BAR(); }
    if (IN(10)) { pg8::Gemm g{HB, (const bf16*)(ws + WS_WDB), M, D, FF}; pg8::StaticOrder S; S.init(M, D, F.G, (int)blockIdx.x);
        pg8::EpiResPre E{X2, X2 + (size_t)MP * D, V, ALPHA, 0.5f}; pg8::gemm_phase<pg8::EpiResPre, pg8::StaticOrder, true, true>(F.lds + RING_OFF, g, S, E); GRID_BAR(); }
    if (IN(11)) { ln_phase(F, V, (const float*)args.in[24], (const float*)args.in[25], out + O_YP, out + O_YS, nullptr); }
#undef IN
#undef GRID_BAR
}

extern "C" void kernel_launch(void* const* d_in, const int* in_sizes, int n_in, void* d_out, int out_size, void* d_ws, size_t ws_size, hipStream_t stream) {
    static int grid = 0;
    if (grid == 0) {
        if (n_in != 26 || (size_t)out_size != O_END || ws_size < WS_END) { fprintf(stderr, "kernel_launch: unexpected shapes (n_in %d out %d ws %zu)\n", n_in, out_size, ws_size); grid = -1; return; }
        int dev = 0, cus = 0, per_cu = 0;
        if (hipGetDevice(&dev) != hipSuccess || hipDeviceGetAttribute(&cus, hipDeviceAttributeMultiprocessorCount, dev) != hipSuccess) { grid = -1; return; }
        if (hipFuncSetAttribute((const void*)mk_fwd, hipFuncAttributeMaxDynamicSharedMemorySize, LDS_BYTES) != hipSuccess) { fprintf(stderr, "kernel_launch: hipFuncSetAttribute failed\n"); grid = -1; return; }
        if (hipOccupancyMaxActiveBlocksPerMultiprocessor(&per_cu, (const void*)mk_fwd, NWAVES * 64, LDS_BYTES) != hipSuccess || per_cu < 1)
            fprintf(stderr, "kernel_launch: occupancy query reports %d workgroups per CU\n", per_cu);
        (void)hipGetLastError();
        grid = cus;
    }
    if (grid < 0) return;
    if (hipMemsetAsync((char*)d_ws + WS_CTL, 0, CTL_ZERO_BYTES, stream) != hipSuccess) return;
    KArgs a{};
    for (int i = 0; i < 26; ++i) a.in[i] = d_in[i];
    a.out = (float*)d_out; a.ws = (unsigned char*)d_ws; a.ph_lo = 0; a.ph_hi = 12;
    hipLaunchKernelGGL(mk_fwd, dim3(grid), dim3(NWAVES * 64), LDS_BYTES, stream, a);
}
```

```cpp
#include <hip/hip_runtime.h>
#include <cstdio>
#include <cstdint>
namespace pg8 {
#define PG8_LAS __attribute__((address_space(3)))
typedef unsigned short bf16_t;
typedef short bf16x8 __attribute__((ext_vector_type(8)));
typedef float f32x4 __attribute__((ext_vector_type(4)));
typedef unsigned u32x4 __attribute__((ext_vector_type(4)));
constexpr int BM = 256, BK = 64, HALF = 128, HTB = HALF * BK * 2  , STAGE_BYTES = 8 * HTB, NXCD = 8, WGM = 8;

__host__ __device__ __forceinline__ int lds_byte(int r, int c) { const int st = (r >> 4) * 2 + (c >> 5), rr = r & 15, cc = c & 31, ob = rr * 64 + cc * 2; return st * 1024 + (ob ^ (((ob >> 9) & 1) << 5)); }
__host__ __device__ __forceinline__ void stage_rc(int b, int& R, int& C) { const int st = b / 1024, sb = b % 1024, swz = sb ^ (((sb >> 9) & 1) << 5); R = (st >> 1) * 16 + swz / 64; C = (st & 1) * 32 + (swz % 64) / 2; }
__host__ __device__ __forceinline__ int perm32(int rho) { const int n = rho >> 4, i = rho & 15; return 8 * (i >> 2) + 4 * n + (i & 3); }

struct Unit { int pm, pn; };
struct Gemm { const bf16_t* A; const bf16_t* Bt; int M, N, K; };

struct StaticOrder {
    int nM, nN, nwg, G, c;
    __host__ __device__ void init(int M, int N, int G_, int c_) { nM = M / BM; nN = N / BM; nwg = nM * nN; G = G_; c = c_; }
    __host__ __device__ bool next(int i, Unit& u) const {
        const long L = (long)i * G + c; if (L >= nwg) return false;
        int wgid = (int)L; { const int q = nwg / NXCD, r = nwg % NXCD, xcd = wgid % NXCD, off = wgid / NXCD; wgid = (xcd < r ? xcd * (q + 1) : r * (q + 1) + (xcd - r) * q) + off; }
        const int nig = WGM * nN, gid = wgid / nig, fm = gid * WGM, gsz = (nM - fm) < WGM ? (nM - fm) : WGM;
        u.pm = fm + ((wgid % nig) % gsz); u.pn = (wgid % nig) / gsz; return true;
    }
    __device__ __forceinline__ void a_ready(const Unit&) const {}
    __device__ __forceinline__ void done(const Unit&) const {}
};

__device__ __forceinline__ unsigned cvt_pk_bf16(float lo, float hi) { unsigned r; asm volatile("v_cvt_pk_bf16_f32 %0, %1, %2" : "=v"(r) : "v"(lo), "v"(hi)); return r; }
typedef float f32x2 __attribute__((ext_vector_type(2)));
template <class Epi, class Sched, bool ALIGN_EPI = false, bool SP2 = false>
__device__ __forceinline__ void gemm_phase(PG8_LAS unsigned char* lds, const Gemm g, const Sched& S, const Epi& E) {
    const int tid = threadIdx.x, wid = __builtin_amdgcn_readfirstlane(tid >> 6), lane = tid & 63, wr = wid >> 2, wc = wid & 3, fr = lane & 15, fq = lane >> 4;
    const int K = g.K, nt = K / BK;
    unsigned voffA[2], voffB[2];
#pragma unroll
    for (int i = 0; i < 2; ++i) { int R, C; stage_rc(tid * 16 + i * 8192, R, C); const int Rb = Epi::PERM ? ((R & ~31) + perm32(R & 31)) : R;
        voffA[i] = (unsigned)(R * K + C) * 2u; voffB[i] = (unsigned)(Rb * K + C) * 2u; }
    const size_t kstep = (size_t)(BK * 2);
    const size_t hstep = (size_t)HALF * K * 2;
    const size_t tstep = 2 * hstep;
    const unsigned ldsw = (unsigned)wid * 1024u;
    const int aoff = lds_byte(wr * 64 + fr, fq * 8), boff = lds_byte(wc * 32 + fr, fq * 8);
#define PG8_SA(b, h) (((b) * 2 + (h)) * HTB)
#define PG8_SB(b, h) ((4 + (b) * 2 + (h)) * HTB)
#define PG8_STAGE(bufoff, gbase, voff) do { _Pragma("unroll") for (int _i = 0; _i < 2; ++_i) \
        __builtin_amdgcn_global_load_lds((const unsigned*)((const char*)(gbase) + (voff)[_i]), (PG8_LAS unsigned*)(lds + (bufoff) + ldsw + _i * 8192), 16, 0, 0); } while (0)
#define PG8_LDA(dst, b, h) do { _Pragma("unroll") for (int m = 0; m < 4; ++m) _Pragma("unroll") for (int k = 0; k < 2; ++k) dst[m][k] = *(const PG8_LAS bf16x8*)(lds + PG8_SA(b, h) + aoff + m * 2048 + k * 1024); } while (0)
#define PG8_LDB(dst, b, h) do { _Pragma("unroll") for (int n = 0; n < 2; ++n) _Pragma("unroll") for (int k = 0; k < 2; ++k) dst[n][k] = *(const PG8_LAS bf16x8*)(lds + PG8_SB(b, h) + boff + n * 2048 + k * 1024); } while (0)
#define PG8_MMA(ai, bj, At, Bt) do { __builtin_amdgcn_s_setprio(1); _Pragma("unroll") for (int m = 0; m < 4; ++m) _Pragma("unroll") for (int n = 0; n < 2; ++n) _Pragma("unroll") for (int k = 0; k < 2; ++k) \
        acc[ai][bj][m][n] = __builtin_amdgcn_mfma_f32_16x16x32_bf16(Bt[n][k], At[m][k], acc[ai][bj][m][n], 0, 0, 0); __builtin_amdgcn_s_setprio(0); } while (0)
#define PG8_WAIT_V(n) asm volatile("s_waitcnt vmcnt(" #n ")" ::: "memory")
#define PG8_WAIT_L(n) asm volatile("s_waitcnt lgkmcnt(" #n ")" ::: "memory")
#define PG8_BAR __builtin_amdgcn_s_barrier()
#define PG8_SCHED __builtin_amdgcn_sched_barrier(0)
    Unit cur, nxt; int ui = 0;
    if (!S.next(0, cur)) return;
    f32x4 acc[2][2][4][2];
#pragma unroll
    for (int a = 0; a < 2; ++a)
#pragma unroll
        for (int b = 0; b < 2; ++b)
#pragma unroll
            for (int m = 0; m < 4; ++m)
#pragma unroll
                for (int n = 0; n < 2; ++n) acc[a][b][m][n] = (f32x4){0.f, 0.f, 0.f, 0.f};
    bf16x8 At[4][2], B0[2][2], B1[2][2];
    const char* cA = (const char*)g.A + (size_t)cur.pm * tstep; const char* cB = (const char*)g.Bt + (size_t)cur.pn * tstep;
    S.a_ready(cur);
    if constexpr (SP2) {
        PG8_STAGE(PG8_SB(0, 0), cB, voffB); PG8_STAGE(PG8_SB(0, 1), cB + hstep, voffB); PG8_STAGE(PG8_SA(0, 0), cA, voffA); PG8_STAGE(PG8_SA(0, 1), cA + hstep, voffA);
        if (wr == 1) PG8_BAR;
        PG8_WAIT_V(2); PG8_BAR;
        PG8_STAGE(PG8_SB(1, 0), cB + kstep, voffB); PG8_STAGE(PG8_SA(1, 0), cA + kstep, voffA); PG8_STAGE(PG8_SB(1, 1), cB + hstep + kstep, voffB);
        PG8_WAIT_V(6); PG8_BAR;
    } else {
        PG8_STAGE(PG8_SB(0, 0), cB, voffB); PG8_STAGE(PG8_SA(0, 0), cA, voffA); PG8_STAGE(PG8_SB(0, 1), cB + hstep, voffB); PG8_STAGE(PG8_SA(0, 1), cA + hstep, voffA);
        if (wr == 1) PG8_BAR;
        PG8_WAIT_V(4); PG8_BAR;
        PG8_STAGE(PG8_SB(1, 0), cB + kstep, voffB); PG8_STAGE(PG8_SA(1, 0), cA + kstep, voffA); PG8_STAGE(PG8_SB(1, 1), cB + hstep + kstep, voffB);
        PG8_WAIT_V(6); PG8_BAR;
    }
    for (;;) {
        const bool has_next = S.next(ui + 1, nxt);
        const char* nA = has_next ? (const char*)g.A + (size_t)nxt.pm * tstep : cA; const char* nB = has_next ? (const char*)g.Bt + (size_t)nxt.pn * tstep : cB;
        for (int t = 0; t < nt; t += 2) {
            const bool last = (t == nt - 2);
            const char* a1 = cA + (size_t)(t + 1) * kstep;
            const char* a2 = last ? nA : cA + (size_t)(t + 2) * kstep; const char* b2 = last ? nB : cB + (size_t)(t + 2) * kstep;
            const char* a3 = a2 + kstep; const char* b3 = b2 + kstep;
            if (last && has_next) S.a_ready(nxt);
            if constexpr (SP2) {
            PG8_LDB(B0, 0, 0); PG8_LDB(B1, 0, 1); PG8_SCHED; PG8_LDA(At, 0, 0); PG8_STAGE(PG8_SA(1, 1), a1 + hstep, voffA);
            PG8_WAIT_V(8); PG8_WAIT_L(0); PG8_BAR; PG8_MMA(0, 0, At, B0); PG8_MMA(0, 1, At, B1); PG8_BAR; PG8_SCHED;
            PG8_LDA(At, 0, 1); PG8_STAGE(PG8_SB(0, 0), b2, voffB); PG8_STAGE(PG8_SB(0, 1), b2 + hstep, voffB); PG8_STAGE(PG8_SA(0, 0), a2, voffA);
            PG8_WAIT_V(8); PG8_WAIT_L(0); PG8_BAR; PG8_MMA(1, 0, At, B0); PG8_MMA(1, 1, At, B1); PG8_BAR; PG8_SCHED;
            PG8_LDB(B0, 1, 0); PG8_LDB(B1, 1, 1); PG8_SCHED; PG8_LDA(At, 1, 0); PG8_STAGE(PG8_SA(0, 1), a2 + hstep, voffA);
            PG8_WAIT_V(8); PG8_WAIT_L(0); PG8_BAR; PG8_MMA(0, 0, At, B0); PG8_MMA(0, 1, At, B1); PG8_BAR; PG8_SCHED;
            PG8_LDA(At, 1, 1); PG8_STAGE(PG8_SB(1, 0), b3, voffB); PG8_STAGE(PG8_SB(1, 1), b3 + hstep, voffB); PG8_STAGE(PG8_SA(1, 0), a3, voffA);
            PG8_WAIT_V(8); PG8_WAIT_L(0); PG8_BAR; PG8_MMA(1, 0, At, B0); PG8_MMA(1, 1, At, B1); PG8_BAR; PG8_SCHED;
            } else {
            PG8_LDB(B0, 0, 0); PG8_SCHED; PG8_LDA(At, 0, 0); PG8_STAGE(PG8_SA(1, 1), a1 + hstep, voffA);
            PG8_WAIT_L(8); PG8_BAR; PG8_WAIT_L(0); PG8_MMA(0, 0, At, B0); PG8_BAR; PG8_SCHED;
            PG8_LDB(B1, 0, 1); PG8_STAGE(PG8_SB(0, 0), b2, voffB);
            PG8_BAR; PG8_WAIT_L(0); PG8_MMA(0, 1, At, B1); PG8_BAR;
            PG8_LDA(At, 0, 1); PG8_STAGE(PG8_SA(0, 0), a2, voffA);
            PG8_BAR; PG8_WAIT_L(0); PG8_MMA(1, 0, At, B0); PG8_BAR; PG8_SCHED;
            PG8_STAGE(PG8_SB(0, 1), b2 + hstep, voffB);
            PG8_WAIT_V(6); PG8_BAR; PG8_MMA(1, 1, At, B1); PG8_BAR;
            PG8_LDB(B0, 1, 0); PG8_SCHED; PG8_LDA(At, 1, 0); PG8_STAGE(PG8_SA(0, 1), a2 + hstep, voffA);
            PG8_WAIT_L(8); PG8_BAR; PG8_WAIT_L(0); PG8_MMA(0, 0, At, B0); PG8_BAR; PG8_SCHED;
            PG8_LDB(B1, 1, 1); PG8_STAGE(PG8_SB(1, 0), b3, voffB);
            PG8_BAR; PG8_WAIT_L(0); PG8_MMA(0, 1, At, B1); PG8_BAR;
            PG8_LDA(At, 1, 1); PG8_STAGE(PG8_SA(1, 0), a3, voffA);
            PG8_BAR; PG8_WAIT_L(0); PG8_MMA(1, 0, At, B0); PG8_BAR; PG8_SCHED;
            PG8_STAGE(PG8_SB(1, 1), b3 + hstep, voffB);
            PG8_WAIT_V(6); PG8_BAR; PG8_MMA(1, 1, At, B1); PG8_BAR;
            }
        }
        if constexpr (ALIGN_EPI) { if (wr == 0) PG8_BAR; }
        if constexpr (!Epi::AFTER_DRAIN) { E(acc, cur, wr, wc, fr, fq); S.done(cur); }
        if (!has_next) break;
#pragma unroll
        for (int a = 0; a < 2; ++a)
#pragma unroll
            for (int b = 0; b < 2; ++b)
#pragma unroll
                for (int m = 0; m < 4; ++m)
#pragma unroll
                    for (int n = 0; n < 2; ++n) acc[a][b][m][n] = (f32x4){0.f, 0.f, 0.f, 0.f};
        cur = nxt; cA = nA; cB = nB; ++ui;
        if constexpr (ALIGN_EPI) { if (wr == 1) PG8_BAR; }
    }
    PG8_WAIT_V(0);
    if constexpr (!ALIGN_EPI) { if (wr == 0) PG8_BAR; }
    PG8_BAR;
    if constexpr (Epi::AFTER_DRAIN) { E.fused(acc, cur, wr, wc, fr, fq, lds, wid, lane); S.done(cur); }
#undef PG8_SA
#undef PG8_SB
#undef PG8_STAGE
#undef PG8_LDA
#undef PG8_LDB
#undef PG8_MMA
#undef PG8_WAIT_V
#undef PG8_WAIT_L
#undef PG8_BAR
#undef PG8_SCHED
}
}
constexpr int NWAVES = 8;
constexpr int D = 1024, FF = 2816, NGU = 2 * FF, NINP = 3072, DIN = 2840;
constexpr int NB = 16, T = 2048, MP = NB * T, SB = 32, SS = 4, MS = SB * SS, MR = MP + MS, M = 33024;
constexpr int DC = 512, DA = 512, HD = 64, NH = 8, NKV = 2, KVW = 256;
constexpr int PAST = 16384, PAGE = 128, NPAGES = PAST / PAGE, BLK = 64, NSEL = 16, WIN = 512;
constexpr int NBP = T / BLK  , NBS = PAST / BLK  ;
constexpr float ALPHA = 1.189207115002721f, LN_EPS = 1e-5f;
constexpr float QSCALE = 0.125f * 1.4426950408889634f;
constexpr size_t O_YP = 0, O_YS = (size_t)MP * D, O_PCMP = O_YS + (size_t)MS * D, O_PSEL = O_PCMP + (size_t)MP * KVW, O_PWIN = O_PSEL + (size_t)MP * KVW,
                 O_PCONV = O_PWIN + (size_t)NB * WIN * KVW, O_SCMP = O_PCONV + (size_t)NB * 2 * DC, O_SSEL = O_SCMP + (size_t)MS * KVW, O_SWIN = O_SSEL + (size_t)MS * KVW,
                 O_SCONV = O_SWIN + (size_t)SB * WIN * KVW, O_END = O_SCONV + (size_t)SB * 2 * DC;
static_assert(O_END == 56868864, "output size");
constexpr size_t MiB = 1u << 20;
constexpr size_t WS_CTL = 0, CTL_ZERO_BYTES = 1 * MiB;
constexpr size_t WS_WGUA = 2 * MiB, WS_WDA = 14 * MiB, WS_WIN = 20 * MiB, WS_WOUT = 26 * MiB, WS_WGUB = 28 * MiB, WS_WDB = 40 * MiB, WS_W1T = 46 * MiB, WS_BIASP = 47 * MiB;
constexpr size_t WS_KC = 48 * MiB;
constexpr size_t WS_XB = 64 * MiB;
constexpr size_t WS_H = 130 * MiB;
constexpr size_t WS_V = 308 * MiB;
constexpr size_t WS_X1 = 438 * MiB, WS_X2 = 568 * MiB;
constexpr size_t WS_CB = 698 * MiB;
constexpr size_t WS_U = 731 * MiB;
constexpr size_t WS_Q = 796 * MiB;
constexpr size_t WS_KS = 829 * MiB, WS_KW = 846 * MiB;
constexpr size_t WS_G = 863 * MiB;
constexpr size_t WS_A2 = 868 * MiB;
constexpr size_t WS_SELM = 933 * MiB;
constexpr size_t WS_END = 940 * MiB;
constexpr int CW_TMO = 0, CW_CODE = 1, CW_BAR = 4096;
constexpr int RING_OFF = 0, RING_BYTES = 131072;
constexpr int LDSCTL_OFF = RING_BYTES, MISC_OFF = LDSCTL_OFF + 320;
constexpr int LDS_BYTES = 147456;
namespace pg8 {
typedef unsigned u32x2 __attribute__((ext_vector_type(2)));
__device__ __forceinline__ float silu_mul(float g, float u) { return g * u * __builtin_amdgcn_rcpf(1.0f + __builtin_amdgcn_exp2f(-1.4426950408889634f * g)); }
struct EpiSwiGLU {
    static constexpr bool PERM = true, AFTER_DRAIN = false;
    bf16_t* H;
    __device__ __forceinline__ void operator()(const f32x4 (&acc)[2][2][4][2], const Unit& u, int wr, int wc, int fr, int fq) const {
        const int row0 = u.pm * BM + wr * 64 + fr, col0 = u.pn * HALF + wc * 32 + 8 * fq;
#pragma unroll
        for (int ai = 0; ai < 2; ++ai)
#pragma unroll
            for (int m = 0; m < 4; ++m) {
                const f32x4 g0 = acc[ai][0][m][0], g1 = acc[ai][0][m][1], u0 = acc[ai][1][m][0], u1 = acc[ai][1][m][1];
                u32x4 w;
                w.x = cvt_pk_bf16(silu_mul(g0[0], u0[0]), silu_mul(g0[1], u0[1])); w.y = cvt_pk_bf16(silu_mul(g0[2], u0[2]), silu_mul(g0[3], u0[3]));
                w.z = cvt_pk_bf16(silu_mul(g1[0], u1[0]), silu_mul(g1[1], u1[1])); w.w = cvt_pk_bf16(silu_mul(g1[2], u1[2]), silu_mul(g1[3], u1[3]));
                *(u32x4*)(H + (size_t)(row0 + ai * HALF + m * 16) * FF + col0) = w;
            }
    }
};
struct EpiResPre {
    static constexpr bool PERM = false, AFTER_DRAIN = false;
    const float* base_p; const float* base_s; float* V; float alpha, s;
    __device__ __forceinline__ void operator()(const f32x4 (&acc)[2][2][4][2], const Unit& u, int wr, int wc, int fr, int fq) const {
        const int col0 = u.pn * BM + wc * 32 + 4 * fq;
        const bool sp = (u.pm == MP / BM);
#pragma unroll
        for (int ai = 0; ai < 2; ++ai) {
            if (sp && ai == 1) continue;
#pragma unroll
            for (int m = 0; m < 4; ++m) {
                const int r = u.pm * BM + ai * HALF + wr * 64 + m * 16 + fr;
                const float* brow = sp ? base_s + (size_t)(r - MP) * D : base_p + (size_t)r * D;
                float* vrow = V + (size_t)r * D;
#pragma unroll
                for (int bj = 0; bj < 2; ++bj)
#pragma unroll
                    for (int n = 0; n < 2; ++n) { const int c = col0 + bj * HALF + n * 16; const f32x4 x = *(const f32x4*)(brow + c);
                        *(f32x4*)(vrow + c) = x * alpha + acc[ai][bj][m][n] * s; }
            }
        }
    }
};
struct EpiInProj {
    static constexpr bool PERM = false, AFTER_DRAIN = false;
    const float* biasp; bf16_t* CB; float* U; bf16_t* Q; bf16_t* KS; bf16_t* KW; float* G; float* out;
    __device__ __forceinline__ void operator()(const f32x4 (&acc)[2][2][4][2], const Unit& u, int wr, int wc, int fr, int fq) const {
        const int pn = u.pn; const bool sp = (u.pm == MP / BM);
        const int cl = wc * 32 + 4 * fq;
        f32x4 bv[2][2];
#pragma unroll
        for (int bj = 0; bj < 2; ++bj)
#pragma unroll
            for (int n = 0; n < 2; ++n) bv[bj][n] = *(const f32x4*)(biasp + pn * BM + bj * HALF + cl + n * 16);
#pragma unroll
        for (int ai = 0; ai < 2; ++ai) {
            if (sp && ai == 1) continue;
#pragma unroll
            for (int m = 0; m < 4; ++m) {
                const int r = u.pm * BM + ai * HALF + wr * 64 + m * 16 + fr;
                const int si = r - MP;
                const int tb = r & (T - 1), nb = r >> 11;
                if (pn < 2) {
#pragma unroll
                    for (int bj = 0; bj < 2; ++bj)
#pragma unroll
                        for (int n = 0; n < 2; ++n) { const f32x4 v = acc[ai][bj][m][n] + bv[bj][n]; u32x2 w; w.x = cvt_pk_bf16(v[0], v[1]); w.y = cvt_pk_bf16(v[2], v[3]);
                            *(u32x2*)(CB + (size_t)r * DC + pn * BM + bj * HALF + cl + n * 16) = w; }
                } else if (pn < 6) {
#pragma unroll
                    for (int n = 0; n < 2; ++n) { const f32x4 v = (acc[ai][0][m][n] + bv[0][n]) * (acc[ai][1][m][n] + bv[1][n]); const int ch = (pn - 2) * HALF + cl + n * 16;
                        *(f32x4*)(U + (size_t)r * DC + ch) = v;
                        if (!sp) { if (tb >= T - 2) *(f32x4*)(out + O_PCONV + (size_t)(nb * 2 + (tb - (T - 2))) * DC + ch) = v; }
                        else { const int s = si & 3; if (s >= 2) *(f32x4*)(out + O_SCONV + (size_t)((si >> 2) * 2 + (s - 2)) * DC + ch) = v; } }
                } else if (pn < 8) {
#pragma unroll
                    for (int bj = 0; bj < 2; ++bj)
#pragma unroll
                        for (int n = 0; n < 2; ++n) { const f32x4 v = (acc[ai][bj][m][n] + bv[bj][n]) * QSCALE; u32x2 w; w.x = cvt_pk_bf16(v[0], v[1]); w.y = cvt_pk_bf16(v[2], v[3]);
                            *(u32x2*)(Q + (size_t)r * DA + (pn - 6) * BM + bj * HALF + cl + n * 16) = w; }
                } else if (pn == 8) {
                    float* o = sp ? out + O_SCMP + (size_t)si * KVW : out + O_PCMP + (size_t)r * KVW;
#pragma unroll
                    for (int bj = 0; bj < 2; ++bj)
#pragma unroll
                        for (int n = 0; n < 2; ++n) *(f32x4*)(o + bj * HALF + cl + n * 16) = acc[ai][bj][m][n] + bv[bj][n];
                } else if (pn == 9) {
                    float* o = sp ? out + O_SSEL + (size_t)si * KVW : out + O_PSEL + (size_t)r * KVW;
#pragma unroll
                    for (int bj = 0; bj < 2; ++bj)
#pragma unroll
                        for (int n = 0; n < 2; ++n) { const f32x4 v = acc[ai][bj][m][n] + bv[bj][n]; *(f32x4*)(o + bj * HALF + cl + n * 16) = v;
                            u32x2 w; w.x = cvt_pk_bf16(v[0], v[1]); w.y = cvt_pk_bf16(v[2], v[3]); *(u32x2*)(KS + (size_t)r * KVW + bj * HALF + cl + n * 16) = w; }
                } else if (pn == 10) {
                    float* o = nullptr;
                    if (sp) o = out + O_SWIN + (size_t)((si >> 2) * WIN + (WIN - SS) + (si & 3)) * KVW;
                    else if (tb >= T - WIN) o = out + O_PWIN + (size_t)(nb * WIN + tb - (T - WIN)) * KVW;
#pragma unroll
                    for (int bj = 0; bj < 2; ++bj)
#pragma unroll
                        for (int n = 0; n < 2; ++n) { const f32x4 v = acc[ai][bj][m][n] + bv[bj][n]; if (o) *(f32x4*)(o + bj * HALF + cl + n * 16) = v;
                            u32x2 w; w.x = cvt_pk_bf16(v[0], v[1]); w.y = cvt_pk_bf16(v[2], v[3]); *(u32x2*)(KW + (size_t)r * KVW + bj * HALF + cl + n * 16) = w; }
                } else {
                    if (wc == 0) {
#pragma unroll
                        for (int n = 0; n < 2; ++n) { if (n == 1 && fq >= 2) continue; f32x4 v = acc[ai][0][m][n] + bv[0][n];
#pragma unroll
                            for (int j = 0; j < 4; ++j) v[j] = __builtin_amdgcn_rcpf(1.0f + __builtin_amdgcn_exp2f(-1.4426950408889634f * v[j]));
                            *(f32x4*)(G + (size_t)r * 32 + cl + n * 16) = v; }
                    }
                }
            }
        }
    }
};
}
#define GAS __attribute__((address_space(1)))
#define LAS __attribute__((address_space(3)))
typedef unsigned short bf16;
typedef unsigned v4u __attribute__((ext_vector_type(4)));
typedef float f32x4 __attribute__((ext_vector_type(4)));
typedef short bf16x8 __attribute__((ext_vector_type(8)));
typedef GAS unsigned gu32;
typedef GAS unsigned long long gu64;
#define RLX_AGENT __ATOMIC_RELAXED, __HIP_MEMORY_SCOPE_AGENT
#define LDS_WAIT() asm volatile("s_waitcnt lgkmcnt(0)" ::: "memory")
#define VM_WAIT() asm volatile("s_waitcnt vmcnt(0)" ::: "memory")
__device__ __forceinline__ unsigned long long rt() { return __builtin_amdgcn_s_memrealtime(); }
__device__ __forceinline__ unsigned f2bf(float f) { unsigned u = __builtin_bit_cast(unsigned, f); return (u + 0x7fffu + ((u >> 16) & 1u)) >> 16; }
__device__ __forceinline__ unsigned pk2(float lo, float hi) { return f2bf(lo) | (f2bf(hi) << 16); }
#define XB_TMO      128
#define XB_XCNT(j)  (256  + 64 * (j))
#define XB_XSUB(j)  (1280 + 64 * (j))
#define XB_XGEN(j)  (2304 + 64 * (j))
#define XB_TOP      3328
#define XB_TOPGEN   3392
#define XCD_BAR_WORDS 3456
#define XB_SPIN_CAP (1u << 18)

__device__ __forceinline__ unsigned xb_ld(unsigned* p)              { return __hip_atomic_load(p, __ATOMIC_RELAXED, __HIP_MEMORY_SCOPE_AGENT); }
__device__ __forceinline__ unsigned xb_add(unsigned* p, unsigned v) { return __hip_atomic_fetch_add(p, v, __ATOMIC_RELAXED, __HIP_MEMORY_SCOPE_AGENT); }
__device__ __forceinline__ unsigned xb_xcc_id() { return (unsigned)__builtin_amdgcn_s_getreg((3 << 11) | 20) & 0xFu; }
#define XB_SPIN(cond, bar) do { unsigned _sp = 0; while (cond) { __builtin_amdgcn_s_sleep(1); \
    if ((++_sp & 255u) == 0u) { if (xb_ld(&(bar)[XB_TMO])) break; if (_sp > XB_SPIN_CAP) { atomicAdd(&(bar)[XB_TMO], 1u); break; } } } } while (0)

struct XcdBarrier {
    unsigned* bar; unsigned x;
    volatile LAS unsigned* st;
};

__device__ __forceinline__ XcdBarrier xcd_barrier_post(unsigned* bar, volatile LAS unsigned* st) {
    XcdBarrier b; b.bar = bar; b.x = xb_xcc_id(); b.st = st;
    if (threadIdx.x == 0) (void)xb_add(&bar[XB_XCNT(b.x)], 1u);
    return b;
}
__device__ __forceinline__ void xcd_barrier_complete(unsigned* bar, unsigned x, unsigned& nloc, unsigned& nx) {
    const unsigned G = gridDim.x * gridDim.y * gridDim.z;
    unsigned sum, cnt, mine, sp = 0u;
    for (;;) {
        sum = 0u; cnt = 0u; mine = 0u;
#pragma unroll
        for (unsigned j = 0; j < 16; ++j) { const unsigned c = xb_ld(&bar[XB_XCNT(j)]); sum += c; cnt += (c > 0u) ? 1u : 0u; mine = (j == x) ? c : mine; }
        if (sum == G) break;
        __builtin_amdgcn_s_sleep(1);
        if ((++sp & 255u) == 0u) { if (xb_ld(&bar[XB_TMO])) break; if (sp > XB_SPIN_CAP) { atomicAdd(&bar[XB_TMO], 1u); break; } }
    }
    nloc = mine > 0u ? mine : 1u; nx = cnt > 0u ? cnt : 1u;
}

__device__ __forceinline__ void xcd_barrier(const XcdBarrier& b) {
    asm volatile("s_waitcnt vmcnt(0)" ::: "memory");
    __syncthreads();
    if (threadIdx.x == 0) {
        unsigned* bar = b.bar;
        __builtin_amdgcn_s_waitcnt(0);
        unsigned nloc = b.st[0], nx = b.st[1];
        if (nloc == 0u) { xcd_barrier_complete(bar, b.x, nloc, nx); b.st[0] = nloc; b.st[1] = nx; }
        const unsigned old = xb_add(&bar[XB_XSUB(b.x)], 1u);
        const unsigned gen = old / nloc;
        if (old + 1u == (gen + 1u) * nloc) {
            __builtin_amdgcn_fence(__ATOMIC_RELEASE, "agent");
            asm volatile("s_waitcnt vmcnt(0)" ::: "memory");
            const unsigned og = xb_add(&bar[XB_TOP], 1u);
            const unsigned tg = og / nx;
            if (og + 1u == (tg + 1u) * nx) xb_add(&bar[XB_TOPGEN], 1u);
            else XB_SPIN(xb_ld(&bar[XB_TOPGEN]) == tg, bar);
            __builtin_amdgcn_fence(__ATOMIC_ACQUIRE, "agent");
            xb_add(&bar[XB_XGEN(b.x)], 1u);
            asm volatile("s_waitcnt vmcnt(0)" ::: "memory");
        } else {
            XB_SPIN(xb_ld(&bar[XB_XGEN(b.x)]) == gen, bar);
            __builtin_amdgcn_fence(__ATOMIC_ACQUIRE, "agent");
            asm volatile("s_waitcnt vmcnt(0)" ::: "memory");
        }
    }
    __syncthreads();
}
struct Frame {
    LAS unsigned char* lds;
    volatile LAS unsigned* MISC;
    gu32* ctl;
    int tid, lane, wave;
    int vcu, G;
};
__device__ __forceinline__ float wave_sum(float v) {
#pragma unroll
    for (int o = 1; o < 64; o <<= 1) v += __shfl_xor(v, o);
    return v;
}
__device__ __forceinline__ float wave_max(float v) {
#pragma unroll
    for (int o = 1; o < 64; o <<= 1) v = fmaxf(v, __shfl_xor(v, o));
    return v;
}
__device__ __forceinline__ void p0_transpose_item(const float* W, int K, int N, bf16* WT, int dst_row0, int k0, int n0, int nvalid, LAS float* scr, int lane) {
#pragma unroll 8
    for (int i = 0; i < 32; ++i) { const int kk = 2 * i + (lane >> 5); const int n = lane & 31; scr[kk * 33 + n] = (n < nvalid) ? W[(size_t)(k0 + kk) * N + n0 + n] : 0.f; }
    LDS_WAIT(); asm volatile("" ::: "memory");
    const int c = lane & 7;
#pragma unroll
    for (int j = 0; j < 4; ++j) { const int n = (lane >> 3) + 8 * j; const LAS float* s = scr + (8 * c) * 33 + n;
        v4u o; o.x = pk2(s[0 * 33], s[1 * 33]); o.y = pk2(s[2 * 33], s[3 * 33]); o.z = pk2(s[4 * 33], s[5 * 33]); o.w = pk2(s[6 * 33], s[7 * 33]);
        *(GAS v4u*)(WT + (size_t)(dst_row0 + n) * K + k0 + 8 * c) = o; }
    LDS_WAIT(); asm volatile("" ::: "memory");
}
__device__ __forceinline__ int map_gu(int n0, int up) { return 256 * (n0 >> 7) + (n0 & 127) + (up ? 128 : 0); }
__device__ __forceinline__ int map_in(int n0) {
    if (n0 < 512) return n0;
    if (n0 < 1024) { const int ch = n0 - 512; return 512 + 256 * (ch >> 7) + (ch & 127); }
    if (n0 < 1536) { const int ch = n0 - 1024; return 512 + 256 * (ch >> 7) + 128 + (ch & 127); }
    return n0;
}
__device__ __forceinline__ int unmap_in(int r) {
    if (r < 512) return r;
    if (r < 1536) { const int t = (r - 512) >> 8, w = (r - 512) & 255; return w < 128 ? 512 + 128 * t + w : 1024 + 128 * t + (w - 128); }
    if (r < DIN) return r;
    return -1;
}
struct KArgs { const void* in[26]; float* out; unsigned char* ws; int ph_lo, ph_hi; };
__device__ __forceinline__ void p0_prologue(Frame& F, const KArgs& a) {
    LAS float* scr = (LAS float*)(F.lds + RING_OFF + F.wave * 16384);
    const int gw = F.vcu * NWAVES + F.wave, NGW = F.G * NWAVES;
    unsigned char* ws = a.ws;
    constexpr int I_GU = (D / 64) * (FF / 32), I_DN = (FF / 64) * (D / 32), I_IN = (D / 64) * ((DIN + 31) / 32), I_OUT = (D / 64) * (D / 32), I_W1 = (4096 / 64) * (64 / 32);
    constexpr int NITEMS = 4 * I_GU + 2 * I_DN + I_IN + I_OUT + 2 * I_W1;
    for (int it = gw; it < NITEMS; it += NGW) {
        int r = it;
        if (r < 4 * I_GU) { const int which = r / I_GU; r -= which * I_GU;
            const float* W = (const float*)a.in[which == 0 ? 7 : which == 1 ? 8 : which == 2 ? 21 : 22]; bf16* WT = (bf16*)(ws + (which < 2 ? WS_WGUA : WS_WGUB));
            const int nblk = FF / 32, kb = r / nblk, nb = r % nblk; p0_transpose_item(W, D, FF, WT, map_gu(32 * nb, which & 1), 64 * kb, 32 * nb, 32, scr, F.lane); continue; }
        r -= 4 * I_GU;
        if (r < 2 * I_DN) { const int which = r / I_DN; r -= which * I_DN;
            const float* W = (const float*)a.in[which == 0 ? 9 : 23]; bf16* WT = (bf16*)(ws + (which == 0 ? WS_WDA : WS_WDB));
            const int nblk = D / 32, kb = r / nblk, nb = r % nblk; p0_transpose_item(W, FF, D, WT, 32 * nb, 64 * kb, 32 * nb, 32, scr, F.lane); continue; }
        r -= 2 * I_DN;
        if (r < I_IN) { const int nblk = (DIN + 31) / 32, kb = r / nblk, nb = r % nblk; const int nv = (DIN - 32 * nb) < 32 ? (DIN - 32 * nb) : 32;
            p0_transpose_item((const float*)a.in[12], D, DIN, (bf16*)(ws + WS_WIN), map_in(32 * nb), 64 * kb, 32 * nb, nv, scr, F.lane); continue; }
        r -= I_IN;
        if (r < I_OUT) { const int nblk = D / 32, kb = r / nblk, nb = r % nblk; p0_transpose_item((const float*)a.in[18], D, D, (bf16*)(ws + WS_WOUT), 32 * nb, 64 * kb, 32 * nb, 32, scr, F.lane); continue; }
        r -= I_OUT;
        { const int c = r / I_W1; r -= c * I_W1; const int kb = r / 2, nb = r % 2;
          p0_transpose_item((const float*)a.in[15] + (size_t)c * 4096 * 64, 4096, 64, (bf16*)(ws + WS_W1T) + (size_t)c * 64 * 4096, 32 * nb, 64 * kb, 32 * nb, 32, scr, F.lane); }
    }
    { const int gt = F.vcu * (NWAVES * 64) + F.tid, NGT = F.G * NWAVES * 64;
      for (int i = gt; i < NINP; i += NGT) { const int s = unmap_in(i); ((float*)(ws + WS_BIASP))[i] = s >= 0 ? ((const float*)a.in[13])[s] : 0.f; }
      constexpr int ZR0 = ((DIN + 31) / 32) * 32; GAS v4u* z = (GAS v4u*)((bf16*)(ws + WS_WIN) + (size_t)ZR0 * D);
      for (int i = gt; i < (NINP - ZR0) * D / 8; i += NGT) z[i] = (v4u){0u, 0u, 0u, 0u};
      const GAS f32x4* sw = (const GAS f32x4*)a.in[4]; GAS f32x4* so = (GAS f32x4*)(a.out + O_SWIN);
      for (int i = gt; i < SB * (WIN - SS) * (KVW / 4); i += NGT) { const int n = i / ((WIN - SS) * (KVW / 4)), rem = i % ((WIN - SS) * (KVW / 4));
          so[(size_t)n * WIN * (KVW / 4) + rem] = sw[(size_t)n * WIN * (KVW / 4) + SS * (KVW / 4) + rem]; }
    }
    for (int m = gw; m < M; m += NGW) {
        GAS unsigned long long* o8 = (GAS unsigned long long*)((bf16*)(ws + WS_XB) + (size_t)m * D) + F.lane;
        if (m >= MR) {
#pragma unroll
            for (int j = 0; j < 4; ++j) o8[64 * j] = 0ull;
            continue; }
        const float* xrow = m < MP ? (const float*)a.in[0] + (size_t)m * D : (const float*)a.in[1] + (size_t)(m - MP) * D;
        const GAS f32x4* xr = (const GAS f32x4*)xrow + F.lane;
#pragma unroll
        for (int j = 0; j < 4; ++j) { const f32x4 v = xr[64 * j]; o8[64 * j] = (unsigned long long)pk2(v.x, v.y) | ((unsigned long long)pk2(v.z, v.w) << 32); }
    }
}
__device__ __forceinline__ void ln_phase(Frame& F, const float* V, const float* gam, const float* bet, float* of_p, float* of_s, bf16* XB) {
    const int gw = F.vcu * NWAVES + F.wave, NGW = F.G * NWAVES;
    f32x4 g4[4], b4[4];
#pragma unroll
    for (int j = 0; j < 4; ++j) { g4[j] = ((const GAS f32x4*)gam)[F.lane + 64 * j]; b4[j] = ((const GAS f32x4*)bet)[F.lane + 64 * j]; }
    for (int m = gw; m < M; m += NGW) {
        if (m >= MR) { if (XB) { GAS unsigned long long* o8 = (GAS unsigned long long*)(XB + (size_t)m * D) + F.lane;
#pragma unroll
                for (int j = 0; j < 4; ++j) o8[64 * j] = 0ull; }
            continue; }
        const GAS f32x4* xr = (const GAS f32x4*)(V + (size_t)m * D) + F.lane;
        f32x4 v[4]; float s = 0.f;
#pragma unroll
        for (int j = 0; j < 4; ++j) { v[j] = xr[64 * j]; s += (v[j].x + v[j].y) + (v[j].z + v[j].w); }
        const float mean = wave_sum(s) * (1.f / D); float s2 = 0.f;
#pragma unroll
        for (int j = 0; j < 4; ++j) { v[j] = v[j] - mean; s2 += (v[j].x * v[j].x + v[j].y * v[j].y) + (v[j].z * v[j].z + v[j].w * v[j].w); }
        const float rstd = 1.f / sqrtf(wave_sum(s2) * (1.f / D) + LN_EPS);
        float* orow = m < MP ? of_p + (size_t)m * D : of_s + (size_t)(m - MP) * D;
        GAS f32x4* of = (GAS f32x4*)orow + F.lane;
#pragma unroll
        for (int j = 0; j < 4; ++j) { v[j] = v[j] * rstd * g4[j] + b4[j]; of[64 * j] = v[j]; }
        if (XB) { GAS unsigned long long* o8 = (GAS unsigned long long*)(XB + (size_t)m * D) + F.lane;
#pragma unroll
            for (int j = 0; j < 4; ++j) o8[64 * j] = (unsigned long long)pk2(v[j].x, v[j].y) | ((unsigned long long)pk2(v[j].z, v[j].w) << 32); }
    }
}
__device__ __forceinline__ void conv_phase(Frame& F, const KArgs& a) {
    const int gw = F.vcu * NWAVES + F.wave, NGW = F.G * NWAVES;
    const float* U = (const float*)(a.ws + WS_U); const bf16* CB = (const bf16*)(a.ws + WS_CB); bf16* A2 = (bf16*)(a.ws + WS_A2);
    const float* wc = (const float*)a.in[14]; const float* sc = (const float*)a.in[5];
    f32x4 w0[2], w1[2], w2[2];
#pragma unroll
    for (int j = 0; j < 2; ++j) { const int ch = 4 * F.lane + 256 * j; w0[j] = *(const GAS f32x4*)(wc + ch); w1[j] = *(const GAS f32x4*)(wc + DC + ch); w2[j] = *(const GAS f32x4*)(wc + 2 * DC + ch); }
    for (int m = gw; m < MR; m += NGW) {
#pragma unroll
        for (int j = 0; j < 2; ++j) {
            const int ch = 4 * F.lane + 256 * j;
            const f32x4 uc = *(const GAS f32x4*)(U + (size_t)m * DC + ch);
            f32x4 u1, u2;
            if (m < MP) { const int t = m & (T - 1);
                u1 = t >= 1 ? *(const GAS f32x4*)(U + (size_t)(m - 1) * DC + ch) : (f32x4){0.f, 0.f, 0.f, 0.f};
                u2 = t >= 2 ? *(const GAS f32x4*)(U + (size_t)(m - 2) * DC + ch) : (f32x4){0.f, 0.f, 0.f, 0.f};
            } else { const int si = m - MP, n = si >> 2, s = si & 3;
                u1 = s >= 1 ? *(const GAS f32x4*)(U + (size_t)(m - 1) * DC + ch) : *(const GAS f32x4*)(sc + (size_t)(n * 2 + 1) * DC + ch);
                u2 = s >= 2 ? *(const GAS f32x4*)(U + (size_t)(m - 2) * DC + ch) : *(const GAS f32x4*)(sc + (size_t)(n * 2 + s) * DC + ch);
            }
            const unsigned long long cbw = *(const GAS unsigned long long*)(CB + (size_t)m * DC + ch);
            f32x4 cb; cb.x = __uint_as_float((unsigned)(cbw & 0xffffu) << 16); cb.y = __uint_as_float((unsigned)((cbw >> 16) & 0xffffu) << 16);
            cb.z = __uint_as_float((unsigned)((cbw >> 32) & 0xffffu) << 16); cb.w = __uint_as_float((unsigned)((cbw >> 48) & 0xffffu) << 16);
            const f32x4 y = cb * (w0[j] * u2 + w1[j] * u1 + w2[j] * uc);
            *(GAS unsigned long long*)(A2 + (size_t)m * D + DA + ch) = (unsigned long long)pk2(y.x, y.y) | ((unsigned long long)pk2(y.z, y.w) << 32);
        }
    }
}
constexpr int CMP_NBLKS = NB * NBP + SB * NBS, CMP_UB = 34, CMP_UNITS = CMP_NBLKS / CMP_UB;
static_assert(CMP_UNITS * CMP_UB == CMP_NBLKS, "compress units");
constexpr int CL_PTR = 0, CL_A = 1024, CL_ABYTES = CMP_UB * 512, CL_HID = 36864;
static_assert(CL_A + 2 * CL_ABYTES <= CL_HID, "compress LDS map");
__device__ __forceinline__ void compress_phase(Frame& F, const KArgs& a) {
    typedef short bf16x8v __attribute__((ext_vector_type(8)));
    const int tid = F.tid, lane = F.lane, wid = F.wave;
    const float* pe = (const float*)a.in[17]; const float* w2 = (const float*)a.in[16];
    const bf16* W1T = (const bf16*)(a.ws + WS_W1T); float* KC = (float*)(a.ws + WS_KC);
    const int* pt = (const int*)a.in[6]; const float* pool = (const float*)a.in[2];
    LAS unsigned long long* ptrs = (LAS unsigned long long*)(F.lds + CL_PTR);
    LAS float* hid = (LAS float*)(F.lds + CL_HID);
    const int c_w = wid >> 2, hq = wid & 3;
    for (int unit = F.vcu; unit < CMP_UNITS; unit += F.G) {
        const int blk0 = unit * CMP_UB;
        __syncthreads();
        if (tid < CMP_UB) { const int id = blk0 + tid; const float* src;
            if (id < NB * NBP) { const int n = id >> 5, b = id & 31; src = a.out + O_PCMP + (size_t)(n * T + b * BLK) * KVW; }
            else { const int sid = id - NB * NBP, n = sid >> 8, b = sid & 255; const int page = pt[n * NPAGES + (b >> 1)]; src = pool + ((size_t)page * PAGE + (size_t)(b & 1) * BLK) * KVW; }
            ptrs[tid] = (unsigned long long)(uintptr_t)src; }
        __syncthreads();
        const float* sp[5]; int e4[5]; bool ok[5];
#pragma unroll
        for (int k = 0; k < 5; ++k) { const int f = tid + 512 * k; ok[k] = f < CMP_UB * 64; const int b = ok[k] ? (f >> 6) : 0; e4[k] = f & 63; sp[k] = (const float*)(uintptr_t)ptrs[b] + e4[k] * 4; }
        f32x4 st[5]; bf16x8v bw[2];
#pragma unroll
        for (int k = 0; k < 5; ++k) if (ok[k]) st[k] = *(const GAS f32x4*)(sp[k]);
        const bf16* wrow = W1T + ((size_t)c_w * 64 + hq * 16 + (lane & 15)) * 4096 + 8 * (lane >> 4);
        bw[0] = *(const GAS bf16x8v*)(wrow); bw[1] = *(const GAS bf16x8v*)(wrow + 32);
        f32x4 acc[5];
#pragma unroll
        for (int mt = 0; mt < 5; ++mt) acc[mt] = (f32x4){0.f, 0.f, 0.f, 0.f};
        for (int p = 0; p < BLK; ++p) {
            LAS unsigned char* abuf = F.lds + CL_A + (p & 1) * CL_ABYTES;
#pragma unroll
            for (int k = 0; k < 5; ++k) if (ok[k]) { const int f = tid + 512 * k; const f32x4 pv = *(const GAS f32x4*)(pe + p * 128 + (e4[k] >> 5) * 64 + (e4[k] & 15) * 4); const f32x4 v = st[k] + pv;
                *(LAS unsigned long long*)(abuf + (f >> 6) * 512 + e4[k] * 8) = (unsigned long long)pk2(v.x, v.y) | ((unsigned long long)pk2(v.z, v.w) << 32); }
            const bf16x8v b0 = bw[0], b1 = bw[1];
            if (p + 1 < BLK) {
#pragma unroll
                for (int k = 0; k < 5; ++k) if (ok[k]) st[k] = *(const GAS f32x4*)(sp[k] + (size_t)(p + 1) * KVW);
                bw[0] = *(const GAS bf16x8v*)(wrow + (p + 1) * 64); bw[1] = *(const GAS bf16x8v*)(wrow + (p + 1) * 64 + 32);
            }
            __syncthreads();
#pragma unroll
            for (int mt = 0; mt < 5; ++mt) { int row = mt * 16 + (lane & 15); if (row >= 2 * CMP_UB) row = 2 * CMP_UB - 1;
                const LAS unsigned char* ap = abuf + (row >> 1) * 512 + (c_w * 128 + (row & 1) * 64 + 8 * (lane >> 4)) * 2;
                const bf16x8v a0 = *(const LAS bf16x8v*)(ap), a1 = *(const LAS bf16x8v*)(ap + 64);
                acc[mt] = __builtin_amdgcn_mfma_f32_16x16x32_bf16(a0, b0, acc[mt], 0, 0, 0);
                acc[mt] = __builtin_amdgcn_mfma_f32_16x16x32_bf16(a1, b1, acc[mt], 0, 0, 0); }
        }
#pragma unroll
        for (int mt = 0; mt < 5; ++mt)
#pragma unroll
            for (int i = 0; i < 4; ++i) { const int row = mt * 16 + (lane >> 4) * 4 + i; const float x = acc[mt][i];
                hid[(c_w * 80 + row) * 64 + hq * 16 + (lane & 15)] = x * __builtin_amdgcn_rcpf(1.0f + __builtin_amdgcn_exp2f(-1.4426950408889634f * x)); }
        __syncthreads();
        for (int pr = wid; pr < 2 * 2 * CMP_UB; pr += NWAVES) { const int c = pr / (2 * CMP_UB), row = pr % (2 * CMP_UB);
            const LAS float* hr = hid + (c * 80 + row) * 64; const float* wp = w2 + (size_t)c * 64 * 64 + lane; float s = 0.f;
#pragma unroll 16
            for (int h = 0; h < 64; ++h) s += hr[h] * wp[h * 64];
            KC[(size_t)(blk0 + (row >> 1)) * 256 + c * 128 + (row & 1) * 64 + lane] = s; }
    }
}
__device__ __forceinline__ float bf2f(unsigned short x) { return __uint_as_float((unsigned)x << 16); }
__device__ __forceinline__ int wave_min_i(int v) {
#pragma unroll
    for (int o = 1; o < 64; o <<= 1) { const int t = __shfl_xor(v, o); v = t < v ? t : v; }
    return v;
}
template <bool F32> __device__ __forceinline__ void dot4h(const void* krow, const LAS float* qf, float (&s)[4]) {
    s[0] = s[1] = s[2] = s[3] = 0.f;
    if (F32) {
#pragma unroll
        for (int d4 = 0; d4 < 16; ++d4) { const f32x4 k = ((const GAS f32x4*)krow)[d4];
#pragma unroll
            for (int h = 0; h < 4; ++h) { const f32x4 q = ((const LAS f32x4*)qf)[h * 16 + d4]; s[h] += (k.x * q.x + k.y * q.y) + (k.z * q.z + k.w * q.w); } }
    } else {
#pragma unroll
        for (int d8 = 0; d8 < 8; ++d8) { const v4u kk = ((const GAS v4u*)krow)[d8];
            const f32x4 k0 = {__uint_as_float(kk.x << 16), __uint_as_float(kk.x & 0xffff0000u), __uint_as_float(kk.y << 16), __uint_as_float(kk.y & 0xffff0000u)};
            const f32x4 k1 = {__uint_as_float(kk.z << 16), __uint_as_float(kk.z & 0xffff0000u), __uint_as_float(kk.w << 16), __uint_as_float(kk.w & 0xffff0000u)};
#pragma unroll
            for (int h = 0; h < 4; ++h) { const f32x4 q0 = ((const LAS f32x4*)qf)[h * 16 + 2 * d8], q1 = ((const LAS f32x4*)qf)[h * 16 + 2 * d8 + 1];
                s[h] += ((k0.x * q0.x + k0.y * q0.y) + (k0.z * q0.z + k0.w * q0.w)) + ((k1.x * q1.x + k1.y * q1.y) + (k1.z * q1.z + k1.w * q1.w)); } }
    }
}
__device__ __forceinline__ void osm_update(const float (&s)[4], bool valid, float (&m)[4], float (&l)[4], float (&o)[4], LAS float* pb, int lane) {
#pragma unroll
    for (int h = 0; h < 4; ++h) {
        const float mb = wave_max(valid ? s[h] : -INFINITY);
        const float mn = fmaxf(m[h], mb);
        const float al = (m[h] == -INFINITY) ? 0.f : __builtin_amdgcn_exp2f(m[h] - mn);
        const float p = valid ? __builtin_amdgcn_exp2f(s[h] - mn) : 0.f;
        l[h] = l[h] * al + wave_sum(p); o[h] *= al; m[h] = mn; pb[h * 64 + lane] = p;
    }
}
template <bool SAMPLE> __device__ __forceinline__ void attn_task(Frame& F, const KArgs& a, int n, int g, int tq) {
    const int lane = F.lane;
    LAS float* wl = (LAS float*)(F.lds + F.wave * 16384);
    LAS float* qf = wl; LAS float* pb = wl + 256; LAS int* sl = (LAS int*)(wl + 256 + 1024);
    const int row = SAMPLE ? MP + n * SS + tq : n * T + tq;
    const int qpos = SAMPLE ? PAST + tq : tq;
    const unsigned char* ws = a.ws;
    const bf16* Q = (const bf16*)(ws + WS_Q); const bf16* KS = (const bf16*)(ws + WS_KS); const bf16* KW = (const bf16*)(ws + WS_KW);
    LDS_WAIT(); asm volatile("" ::: "memory");
#pragma unroll
    for (int h = 0; h < 4; ++h) qf[h * 64 + lane] = bf2f(Q[(size_t)row * DA + (g * 4 + h) * 64 + lane]);
    LDS_WAIT(); asm volatile("" ::: "memory");
    constexpr int NBLK = SAMPLE ? NBS : NBP, NC = SAMPLE ? 4 : 1;
    const float* KC = (const float*)(ws + WS_KC) + (size_t)(SAMPLE ? (NB * NBP + n * NBS) : n * NBP) * 256;
    float imp[NC]; float ocmp[4] = {0.f, 0.f, 0.f, 0.f};
    {
#pragma unroll 1
        for (int jj = 0; jj < NC; ++jj) { const int j = lane + 64 * jj; const bool vis = (j < NBLK) && ((j + 1) * BLK - 1 <= qpos);
            if (j < NBLK) { float s4[4]; dot4h<true>(KC + (size_t)j * 256 + g * 64, qf, s4);
#pragma unroll
                for (int h = 0; h < 4; ++h) pb[h * 256 + j] = vis ? s4[h] : -INFINITY; } }
        LDS_WAIT(); asm volatile("" ::: "memory");
#pragma unroll
        for (int jj = 0; jj < NC; ++jj) imp[jj] = 0.f;
#pragma unroll
        for (int h = 0; h < 4; ++h) {
            float sv[NC]; float mx = -INFINITY;
#pragma unroll
            for (int jj = 0; jj < NC; ++jj) { sv[jj] = (lane + 64 * jj < NBLK) ? pb[h * 256 + lane + 64 * jj] : -INFINITY; mx = fmaxf(mx, sv[jj]); }
            mx = wave_max(mx);
            float e[NC], sum = 0.f;
#pragma unroll
            for (int jj = 0; jj < NC; ++jj) { e[jj] = (sv[jj] > -INFINITY) ? __builtin_amdgcn_exp2f(sv[jj] - mx) : 0.f; sum += e[jj]; }
            sum = wave_sum(sum); const float inv = sum > 0.f ? 1.0f / sum : 0.f;
#pragma unroll
            for (int jj = 0; jj < NC; ++jj) { const float p = e[jj] * inv; imp[jj] += p; if (lane + 64 * jj < NBLK) pb[h * 256 + lane + 64 * jj] = p; }
        }
        LDS_WAIT(); asm volatile("" ::: "memory");
        int nvis = (qpos + 1) / BLK; if (nvis > NBLK) nvis = NBLK;
        for (int j = 0; j < nvis; ++j) { const float v = KC[(size_t)j * 256 + 128 + g * 64 + lane];
#pragma unroll
            for (int h = 0; h < 4; ++h) ocmp[h] += pb[h * 256 + j] * v; }
        LDS_WAIT(); asm volatile("" ::: "memory");
    }
    const int cur = qpos >> 6;
    {
        float cand[NC];
#pragma unroll
        for (int jj = 0; jj < NC; ++jj) { const int j = lane + 64 * jj;
            cand[jj] = (j >= NBLK) ? -INFINITY : (j > cur) ? -1e30f : (j == 0 || j == cur || j == cur - 1) ? 1e4f : imp[jj]; }
        constexpr int NIT = SAMPLE ? NSEL - 1 : NSEL;
        for (int it = 0; it < NIT; ++it) {
            float lm = cand[0];
#pragma unroll
            for (int jj = 1; jj < NC; ++jj) lm = fmaxf(lm, cand[jj]);
            const float mx = wave_max(lm);
            int lj = 0x7fffffff;
#pragma unroll
            for (int jj = NC - 1; jj >= 0; --jj) if (cand[jj] == mx) lj = lane + 64 * jj;
            const int sj = wave_min_i(lj);
            if (lane == 0) sl[it] = sj;
#pragma unroll
            for (int jj = 0; jj < NC; ++jj) if (lane + 64 * jj == sj) cand[jj] = -INFINITY;
        }
        if (SAMPLE) { if (lane == 0) sl[NSEL - 1] = NBS; }
        LDS_WAIT(); asm volatile("" ::: "memory");
    }
    float osel[4] = {0.f, 0.f, 0.f, 0.f};
    {
        float m[4] = {-INFINITY, -INFINITY, -INFINITY, -INFINITY}, l[4] = {0.f, 0.f, 0.f, 0.f};
        for (int i = 0; i < NSEL; ++i) {
            const int j = __builtin_amdgcn_readfirstlane(sl[i]);
            if (j > cur) continue;
            const int kpos = j * BLK + lane; const bool valid = kpos <= qpos;
            float s[4];
            if (!SAMPLE) {
                const bf16* kb = KS + (size_t)(n * T + j * BLK) * KVW + g * 64;
                dot4h<false>(kb + (size_t)lane * KVW, qf, s);
                osm_update(s, valid, m, l, osel, pb, lane);
                LDS_WAIT(); asm volatile("" ::: "memory");
                for (int k = 0; k < BLK; ++k) { const float v = bf2f(kb[(size_t)k * KVW + 128 + lane]);
#pragma unroll
                    for (int h = 0; h < 4; ++h) osel[h] += pb[h * 64 + k] * v; }
            } else {
                const float* kb; int nk = BLK;
                if (j < NBS) { const int page = ((const int*)a.in[6])[n * NPAGES + (j >> 1)]; kb = (const float*)a.in[3] + ((size_t)page * PAGE + (size_t)(j & 1) * BLK) * KVW + g * 64; }
                else { kb = a.out + O_SSEL + (size_t)(n * SS) * KVW + g * 64; nk = SS; }
                const int kl = lane < nk ? lane : nk - 1;
                dot4h<true>(kb + (size_t)kl * KVW, qf, s);
                osm_update(s, valid && lane < nk, m, l, osel, pb, lane);
                LDS_WAIT(); asm volatile("" ::: "memory");
                for (int k = 0; k < nk; ++k) { const float v = kb[(size_t)k * KVW + 128 + lane];
#pragma unroll
                    for (int h = 0; h < 4; ++h) osel[h] += pb[h * 64 + k] * v; }
            }
            LDS_WAIT(); asm volatile("" ::: "memory");
        }
#pragma unroll
        for (int h = 0; h < 4; ++h) osel[h] = l[h] > 0.f ? osel[h] / l[h] : 0.f;
    }
    float owin[4] = {0.f, 0.f, 0.f, 0.f};
    {
        float m[4] = {-INFINITY, -INFINITY, -INFINITY, -INFINITY}, l[4] = {0.f, 0.f, 0.f, 0.f};
        for (int c = 0; c < WIN / 64; ++c) {
            float s[4];
            if (!SAMPLE) {
                const int k0 = qpos - (WIN - 1) + 64 * c; if (k0 + 63 < 0) continue;
                const int kpos = k0 + lane; const bool valid = kpos >= 0; const int kc = valid ? kpos : 0;
                dot4h<false>(KW + (size_t)(n * T + kc) * KVW + g * 64, qf, s);
                osm_update(s, valid, m, l, owin, pb, lane);
                LDS_WAIT(); asm volatile("" ::: "memory");
                for (int k = 0; k < 64; ++k) { const int kp = k0 + k; if (kp < 0) continue; const float v = bf2f(KW[(size_t)(n * T + kp) * KVW + 128 + g * 64 + lane]);
#pragma unroll
                    for (int h = 0; h < 4; ++h) owin[h] += pb[h * 64 + k] * v; }
            } else {
                const int i0 = tq + 1 + 64 * c;
                const float* st = (const float*)a.in[4] + (size_t)n * WIN * KVW; const float* nw = a.out + O_SWIN + (size_t)(n * WIN + (WIN - SS)) * KVW;
                const int i = i0 + lane; const float* kr = (i < WIN ? st + (size_t)i * KVW : nw + (size_t)(i - WIN) * KVW) + g * 64;
                dot4h<true>(kr, qf, s);
                osm_update(s, true, m, l, owin, pb, lane);
                LDS_WAIT(); asm volatile("" ::: "memory");
                for (int k = 0; k < 64; ++k) { const int ik = i0 + k; const float v = (ik < WIN ? st + (size_t)ik * KVW : nw + (size_t)(ik - WIN) * KVW)[128 + g * 64 + lane];
#pragma unroll
                    for (int h = 0; h < 4; ++h) owin[h] += pb[h * 64 + k] * v; }
            }
            LDS_WAIT(); asm volatile("" ::: "memory");
        }
#pragma unroll
        for (int h = 0; h < 4; ++h) owin[h] = l[h] > 0.f ? owin[h] / l[h] : 0.f;
    }
    const float* G = (const float*)(ws + WS_G) + (size_t)row * 32; bf16* A2 = (bf16*)(ws + WS_A2);
#pragma unroll
    for (int h = 0; h < 4; ++h) { const int hh = g * 4 + h; const float o = G[hh] * ocmp[h] + G[8 + hh] * osel[h] + G[16 + hh] * owin[h];
        A2[(size_t)row * D + hh * 64 + lane] = (bf16)f2bf(o); }
}
__device__ __forceinline__ void attn_phase(Frame& F, const KArgs& a) {
    { const int gt = F.vcu * (NWAVES * 64) + F.tid, NGT = F.G * NWAVES * 64; bf16* A2 = (bf16*)(a.ws + WS_A2);
      for (int i = gt; i < (M - MR) * (D / 8); i += NGT) *(GAS v4u*)(A2 + (size_t)MR * D + (size_t)i * 8) = (v4u){0u, 0u, 0u, 0u}; }
#ifndef NO_SAMPLE
    for (int task = F.vcu + F.G * F.wave; task < SB * NKV * SS; task += F.G * NWAVES) { const int n = task >> 3, g = (task >> 2) & 1, s = task & 3; attn_task<true>(F, a, n, g, s); }
#endif
#ifndef NO_PROMPT
    const int per = (NB * NKV * T + F.G - 1) / F.G;
    for (int i = F.wave; i < per; i += NWAVES) { const int task = F.vcu * per + i; if (task >= NB * NKV * T) break;
        const int n = task >> 12, g = (task >> 11) & 1, t = task & (T - 1); attn_task<false>(F, a, n, g, t); }
#endif
}
namespace sattn {
constexpr int S_Q = 0, S_SC = 1024, S_SL = 5120, S_PART = 8192, S_ML = 16384, S_PB = 20480, S_OC = 28672, S_OS = 29696;
__device__ __forceinline__ void pv_rows(const float* vb, int nk, const LAS float* pb, float (&o)[4]) {
    if (nk == 64) {
#pragma unroll 16
        for (int k = 0; k < 64; ++k) { const float v = vb[(size_t)k * KVW];
#pragma unroll
            for (int h = 0; h < 4; ++h) o[h] += pb[h * 64 + k] * v; }
    } else {
        for (int k = 0; k < nk; ++k) { const float v = vb[(size_t)k * KVW];
#pragma unroll
            for (int h = 0; h < 4; ++h) o[h] += pb[h * 64 + k] * v; }
    }
}
__device__ __forceinline__ void put_partial(LAS unsigned char* lds, int wid, int lane, const float (&m)[4], const float (&l)[4], const float (&o)[4]) {
    LAS float* part = (LAS float*)(lds + S_PART) + wid * 256; LAS float* ml = (LAS float*)(lds + S_ML) + wid * 8;
#pragma unroll
    for (int h = 0; h < 4; ++h) { part[h * 64 + lane] = o[h]; if (lane == 0) { ml[h * 2] = m[h]; ml[h * 2 + 1] = l[h]; } }
}
__device__ __forceinline__ float combine(const LAS unsigned char* lds, int h, int lane) {
    const LAS float* part = (const LAS float*)(lds + S_PART); const LAS float* ml = (const LAS float*)(lds + S_ML);
    float M = -INFINITY;
#pragma unroll
    for (int w = 0; w < 8; ++w) M = fmaxf(M, ml[w * 8 + h * 2]);
    float o = 0.f, l = 0.f;
#pragma unroll
    for (int w = 0; w < 8; ++w) { const float mw = ml[w * 8 + h * 2]; const float f = (mw == -INFINITY) ? 0.f : __builtin_amdgcn_exp2f(mw - M); o += f * part[w * 256 + h * 64 + lane]; l += f * ml[w * 8 + h * 2 + 1]; }
    return l > 0.f ? o / l : 0.f;
}
__device__ __forceinline__ void task(Frame& F, const KArgs& a, int n, int g, int s) {
    LAS unsigned char* lds = F.lds; const int tid = F.tid, lane = F.lane, wid = F.wave;
    const int row = MP + n * SS + s, qpos = PAST + s;
    const unsigned char* ws = a.ws;
    LAS float* qf = (LAS float*)(lds + S_Q); LAS float* scp = (LAS float*)(lds + S_SC); LAS int* sl = (LAS int*)(lds + S_SL); LAS float* pb = (LAS float*)(lds + S_PB) + wid * 256;
    const float* KC = (const float*)(ws + WS_KC) + (size_t)(NB * NBP + n * NBS) * 256;
    __syncthreads();
    if (tid < 256) qf[tid] = bf2f(((const bf16*)(ws + WS_Q))[(size_t)row * DA + (g * 4 + (tid >> 6)) * 64 + (tid & 63)]);
    __syncthreads();
    { const int j = tid >> 1, dh = tid & 1; const GAS f32x4* kr = (const GAS f32x4*)(KC + (size_t)j * 256 + g * 64 + 32 * dh);
      float sc[4] = {0.f, 0.f, 0.f, 0.f};
#pragma unroll
      for (int d4 = 0; d4 < 8; ++d4) { const f32x4 k = kr[d4];
#pragma unroll
          for (int h = 0; h < 4; ++h) { const f32x4 q = ((const LAS f32x4*)qf)[h * 16 + 8 * dh + d4]; sc[h] += (k.x * q.x + k.y * q.y) + (k.z * q.z + k.w * q.w); } }
#pragma unroll
      for (int h = 0; h < 4; ++h) { sc[h] += __shfl_xor(sc[h], 1); if (dh == 0) scp[h * 256 + j] = sc[h]; } }
    __syncthreads();
    if (wid < 4) { float v[4], mx = -INFINITY;
#pragma unroll
        for (int jj = 0; jj < 4; ++jj) { v[jj] = scp[wid * 256 + lane + 64 * jj]; mx = fmaxf(mx, v[jj]); }
        mx = wave_max(mx); float sum = 0.f;
#pragma unroll
        for (int jj = 0; jj < 4; ++jj) { v[jj] = __builtin_amdgcn_exp2f(v[jj] - mx); sum += v[jj]; }
        sum = wave_sum(sum); const float inv = 1.0f / sum;
#pragma unroll
        for (int jj = 0; jj < 4; ++jj) scp[wid * 256 + lane + 64 * jj] = v[jj] * inv; }
    __syncthreads();
    { float o[4] = {0.f, 0.f, 0.f, 0.f}; const float* vb = KC + (size_t)(32 * wid) * 256 + 128 + g * 64 + lane;
#pragma unroll
      for (int k = 0; k < 32; ++k) { const float v = vb[(size_t)k * 256];
#pragma unroll
          for (int h = 0; h < 4; ++h) o[h] += scp[h * 256 + 32 * wid + k] * v; }
      LAS float* part = (LAS float*)(lds + S_PART) + wid * 256;
#pragma unroll
      for (int h = 0; h < 4; ++h) part[h * 64 + lane] = o[h]; }
    __syncthreads();
    if (wid == 0) {
        float cand[4];
#pragma unroll
        for (int jj = 0; jj < 4; ++jj) { const int j = lane + 64 * jj; const float imp = (scp[j] + scp[256 + j]) + (scp[512 + j] + scp[768 + j]);
            cand[jj] = (j == 0 || j == NBS - 1) ? 1e4f : imp; }
        for (int it = 0; it < NSEL - 1; ++it) {
            const float mx = wave_max(fmaxf(fmaxf(cand[0], cand[1]), fmaxf(cand[2], cand[3])));
            int lj = 0x7fffffff;
#pragma unroll
            for (int jj = 3; jj >= 0; --jj) if (cand[jj] == mx) lj = lane + 64 * jj;
            const int sj = wave_min_i(lj);
            if (lane == 0) sl[it] = sj;
#pragma unroll
            for (int jj = 0; jj < 4; ++jj) if (lane + 64 * jj == sj) cand[jj] = -INFINITY;
        }
        if (lane == 0) sl[NSEL - 1] = NBS;
    } else if (wid <= 4) { const int h = wid - 1; const LAS float* part = (const LAS float*)(lds + S_PART); float o = 0.f;
#pragma unroll
        for (int w = 0; w < 8; ++w) o += part[w * 256 + h * 64 + lane];
        ((LAS float*)(lds + S_OC))[h * 64 + lane] = o; }
    __syncthreads();
    {
        float m[4] = {-INFINITY, -INFINITY, -INFINITY, -INFINITY}, l[4] = {0.f, 0.f, 0.f, 0.f}, o[4] = {0.f, 0.f, 0.f, 0.f};
        for (int i = 2 * wid; i < 2 * wid + 2; ++i) {
            const int j = __builtin_amdgcn_readfirstlane(sl[i]);
            const float* kb; int nk = BLK;
            if (j < NBS) { const int page = ((const int*)a.in[6])[n * NPAGES + (j >> 1)]; kb = (const float*)a.in[3] + ((size_t)page * PAGE + (size_t)(j & 1) * BLK) * KVW + g * 64; }
            else { kb = a.out + O_SSEL + (size_t)(n * SS) * KVW + g * 64; nk = SS; }
            const int kl = lane < nk ? lane : nk - 1; const bool valid = (j * BLK + lane <= qpos) && lane < nk;
            float sc[4]; dot4h<true>(kb + (size_t)kl * KVW, qf, sc);
            osm_update(sc, valid, m, l, o, pb, lane);
            LDS_WAIT(); asm volatile("" ::: "memory");
            pv_rows(kb + 128 + lane, nk, pb, o);
            LDS_WAIT(); asm volatile("" ::: "memory");
        }
        put_partial(lds, wid, lane, m, l, o);
    }
    __syncthreads();
    if (wid < 4) ((LAS float*)(lds + S_OS))[wid * 64 + lane] = combine(lds, wid, lane);
    __syncthreads();
    {
        float m[4] = {-INFINITY, -INFINITY, -INFINITY, -INFINITY}, l[4] = {0.f, 0.f, 0.f, 0.f}, o[4] = {0.f, 0.f, 0.f, 0.f};
        const int i0 = s + 1 + 64 * wid;
        const float* st = (const float*)a.in[4] + (size_t)n * WIN * KVW; const float* nw = a.out + O_SWIN + (size_t)(n * WIN + (WIN - SS)) * KVW;
        const int i = i0 + lane; const float* kr = (i < WIN ? st + (size_t)i * KVW : nw + (size_t)(i - WIN) * KVW) + g * 64;
        float sc[4]; dot4h<true>(kr, qf, sc);
        osm_update(sc, true, m, l, o, pb, lane);
        LDS_WAIT(); asm volatile("" ::: "memory");
        if (i0 + 63 < WIN) pv_rows(st + (size_t)i0 * KVW + 128 + g * 64 + lane, 64, pb, o);
        else { for (int k = 0; k < 64; ++k) { const int ik = i0 + k; const float v = (ik < WIN ? st + (size_t)ik * KVW : nw + (size_t)(ik - WIN) * KVW)[128 + g * 64 + lane];
#pragma unroll
                for (int h = 0; h < 4; ++h) o[h] += pb[h * 64 + k] * v; } }
        put_partial(lds, wid, lane, m, l, o);
    }
    __syncthreads();
    if (wid < 4) { const int hh = g * 4 + wid; const float ow = combine(lds, wid, lane); const float* G = (const float*)(ws + WS_G) + (size_t)row * 32;
        const float o = G[hh] * ((const LAS float*)(lds + S_OC))[wid * 64 + lane] + G[8 + hh] * ((const LAS float*)(lds + S_OS))[wid * 64 + lane] + G[16 + hh] * ow;
        ((bf16*)(ws + WS_A2))[(size_t)row * D + hh * 64 + lane] = (bf16)f2bf(o); }
}
}
namespace pattn {
typedef short bf16x8 __attribute__((ext_vector_type(8)));
typedef short s16x4 __attribute__((ext_vector_type(4)));
typedef float f32x16 __attribute__((ext_vector_type(16)));
constexpr int L_KV = 32768, SLOT = 16384;
constexpr int L_KC = 65536;
constexpr int L_IMP = 0;
constexpr int L_SELM = 73728, L_UNI = L_SELM + 256;
__device__ __forceinline__ int crow(int r, int hi) { return (r & 3) + 8 * (r >> 2) + 4 * hi; }
__device__ __forceinline__ unsigned cvtpk(float lo, float hi) { typedef float f2 __attribute__((ext_vector_type(2))); typedef __bf16 b2 __attribute__((ext_vector_type(2))); f2 v = {lo, hi}; b2 b = __builtin_convertvector(v, b2); return __builtin_bit_cast(unsigned, b); }
__device__ __forceinline__ float swapmax(float v) { auto rr = __builtin_amdgcn_permlane32_swap(__float_as_uint(v), __float_as_uint(v), false, false); return fmaxf(__uint_as_float(rr[0]), __uint_as_float(rr[1])); }
__device__ __forceinline__ float swapsum(float v) { auto rr = __builtin_amdgcn_permlane32_swap(__float_as_uint(v), __float_as_uint(v), false, false); return __uint_as_float(rr[0]) + __uint_as_float(rr[1]); }
typedef short v4i16_t __attribute__((ext_vector_type(4)));
__device__ __forceinline__ s16x4 vtr(const LAS unsigned char* p) { return __builtin_bit_cast(s16x4, __builtin_amdgcn_ds_read_tr16_b64_v4i16((LAS v4i16_t*)p)); }
__device__ __forceinline__ bf16x8 vfrag(const LAS unsigned char* p) { const s16x4 lo = vtr(p), hi = vtr(p + 512); return (bf16x8){lo[0], lo[1], lo[2], lo[3], hi[0], hi[1], hi[2], hi[3]}; }
#define PK8(P, B) __builtin_bit_cast(bf16x8, (v4u){cvtpk(P[B], P[B + 1]), cvtpk(P[B + 2], P[B + 3]), cvtpk(P[B + 4], P[B + 5]), cvtpk(P[B + 6], P[B + 7])})

template <int MODE> __device__ __forceinline__ void block_step(const LAS unsigned char* sb, const bf16x8 (&qr)[4], int j, int c, int tl, unsigned mymask, int r32, int hh, int voff,
                                                               float& m, float& l, f32x16 (&o)[2]) {
    f32x16 p0 = {}, p1 = {};
#pragma unroll
    for (int d0 = 0; d0 < 4; ++d0) { const LAS unsigned char* kb = sb + (2 * d0 + hh) * 1024 + r32 * 16;
        const bf16x8 b0 = *(const LAS bf16x8*)kb, b1 = *(const LAS bf16x8*)(kb + 512);
        p0 = __builtin_amdgcn_mfma_f32_32x32x16_bf16(b0, qr[d0], p0, 0, 0, 0); p1 = __builtin_amdgcn_mfma_f32_32x32x16_bf16(b1, qr[d0], p1, 0, 0, 0); }
    __builtin_amdgcn_sched_barrier(0);
    int tlo = tl; asm volatile("" : "+v"(tlo));
    if (MODE == 0) { if (!((mymask >> j) & 1u)) {
#pragma unroll
            for (int r = 0; r < 16; ++r) { p0[r] = -INFINITY; p1[r] = -INFINITY; } } }
    if (j == c) {
#pragma unroll
        for (int r = 0; r < 16; ++r) { const int kl = crow(r, hh); if (kl > tlo) p0[r] = -INFINITY; if (kl + 32 > tlo) p1[r] = -INFINITY; } }
    if (MODE == 1) { if (j == c - 8) {
#pragma unroll
            for (int r = 0; r < 16; ++r) { const int kl = crow(r, hh); if (kl <= tlo) p0[r] = -INFINITY; if (kl + 32 <= tlo) p1[r] = -INFINITY; } } }
    float mx = fmaxf(p0[0], p1[0]);
#pragma unroll
    for (int r = 1; r < 16; ++r) mx = fmaxf(mx, fmaxf(p0[r], p1[r]));
    mx = swapmax(mx);
    const float mn = fmaxf(m, mx), al = __builtin_amdgcn_exp2f(m - mn); m = mn;
    float s = 0.f;
#pragma unroll
    for (int r = 0; r < 16; ++r) { p0[r] = __builtin_amdgcn_exp2f(p0[r] - mn); p1[r] = __builtin_amdgcn_exp2f(p1[r] - mn); s += p0[r] + p1[r]; }
    l = l * al + s;
#pragma unroll
    for (int r = 0; r < 16; ++r) { o[0][r] *= al; o[1][r] *= al; }
    const bf16x8 pw0 = PK8(p0, 0), pw1 = PK8(p0, 8), pw2 = PK8(p1, 0), pw3 = PK8(p1, 8);
    const LAS unsigned char* vb = sb + 8192 + voff;
    __builtin_amdgcn_sched_barrier(0);
#pragma unroll
    for (int d0 = 0; d0 < 2; ++d0) {
        if (d0 == 1) __builtin_amdgcn_sched_barrier(0);
        o[d0] = __builtin_amdgcn_mfma_f32_32x32x16_bf16(vfrag(vb + (d0 * 4 + 0) * 1024), pw0, o[d0], 0, 0, 0);
        o[d0] = __builtin_amdgcn_mfma_f32_32x32x16_bf16(vfrag(vb + (d0 * 4 + 1) * 1024), pw1, o[d0], 0, 0, 0);
        __builtin_amdgcn_sched_barrier(0);
        o[d0] = __builtin_amdgcn_mfma_f32_32x32x16_bf16(vfrag(vb + (d0 * 4 + 2) * 1024), pw2, o[d0], 0, 0, 0);
        o[d0] = __builtin_amdgcn_mfma_f32_32x32x16_bf16(vfrag(vb + (d0 * 4 + 3) * 1024), pw3, o[d0], 0, 0, 0);
    }
}
template <int MODE> __device__ __forceinline__ void run_branch(LAS unsigned char* lds, const bf16* src, int n, int g, unsigned blocks, const bf16x8 (&qr)[4], int c, int tl, unsigned mymask,
                                                               int tid, int r32, int hh, int voff, float gate, f32x16 (&ofin)[2]) {
    const int lane = tid & 63, wid = tid >> 6;
    float m = -1e30f, l = 0.f; f32x16 o[2] = {};
    const bf16* kg = src + (size_t)(n * T + lane) * KVW + g * 64 + wid * 8;
    const bf16* vg = src + (size_t)(n * T + 16 * (wid & 3) + (lane >> 2)) * KVW + 128 + g * 64 + (wid >> 2) * 32 + (lane & 3) * 8;
    const int kdst = wid * 1024 + lane * 16, vdst = 8192 + wid * 1024 + lane * 16;
    unsigned rem = blocks; int j = __builtin_ctz(rem); rem &= rem - 1;
    v4u kreg = *(const GAS v4u*)(kg + (size_t)j * BLK * KVW), vreg = *(const GAS v4u*)(vg + (size_t)j * BLK * KVW);
    int slot = 0;
    for (;;) {
        LAS unsigned char* sb = lds + L_KV + slot * SLOT;
        *(LAS v4u*)(sb + kdst) = kreg; *(LAS v4u*)(sb + vdst) = vreg;
        const int jn = rem ? __builtin_ctz(rem) : -1;
        if (jn >= 0) { kreg = *(const GAS v4u*)(kg + (size_t)jn * BLK * KVW); vreg = *(const GAS v4u*)(vg + (size_t)jn * BLK * KVW); }
        __syncthreads();
        block_step<MODE>(sb, qr, j, c, tl, mymask, r32, hh, voff, m, l, o);
        if (jn < 0) break;
        j = jn; rem &= rem - 1; slot ^= 1;
    }
    l = swapsum(l);
    const float sc = l > 0.f ? gate / l : 0.f;
#pragma unroll
    for (int r = 0; r < 16; ++r) { ofin[0][r] += sc * o[0][r]; ofin[1][r] += sc * o[1][r]; }
}
__device__ __forceinline__ void unit(Frame& F, const KArgs& a, int n, int g, int c) {
    LAS unsigned char* lds = F.lds;
    int tid = F.tid; asm volatile("" : "+v"(tid));
    const int lane = tid & 63, wid = F.wave, r32 = lane & 31, hh = lane >> 5, hl = wid >> 1, qsub = wid & 1, tl = 32 * qsub + r32;
    const int h = g * 4 + hl, row = n * T + 64 * c + tl;
    const unsigned char* ws = a.ws;
    const bf16* Q = (const bf16*)(ws + WS_Q); const float* KC = (const float*)(ws + WS_KC) + (size_t)(n * NBP) * 256; const float* G = (const float*)(ws + WS_G) + (size_t)row * 32;
    const int voff = ((lane >> 4) & 1) * 32 + (lane & 3) * 8 + (4 * hh + ((lane & 15) >> 2)) * 64;
    __syncthreads();
    { const int j = tid >> 4, d = (tid & 15) * 4;
      const f32x4 kc = *(const GAS f32x4*)(KC + (size_t)j * 256 + g * 64 + d), vc = *(const GAS f32x4*)(KC + (size_t)j * 256 + 128 + g * 64 + d);
      *(LAS unsigned long long*)(lds + L_KC + (d >> 3) * 512 + j * 16 + (d & 7) * 2) = (unsigned long long)pk2(kc.x, kc.y) | ((unsigned long long)pk2(kc.z, kc.w) << 32);
      *(LAS unsigned long long*)(lds + L_KC + 4096 + ((d >> 5) * 2 + (j >> 4)) * 1024 + (j & 15) * 64 + (d & 31) * 2) = (unsigned long long)pk2(vc.x, vc.y) | ((unsigned long long)pk2(vc.z, vc.w) << 32);
      if (tid < 65) ((LAS unsigned*)(lds + L_SELM))[tid] = 0u; }
    bf16x8 qr[4];
#pragma unroll
    for (int d0 = 0; d0 < 4; ++d0) qr[d0] = *(const GAS bf16x8*)(Q + (size_t)row * DA + h * 64 + d0 * 16 + hh * 8);
    const float g_cmp = G[h], g_sel = G[8 + h], g_win = G[16 + h];
    __syncthreads();
    f32x16 ofin[2] = {};
    {
        f32x16 p = {};
#pragma unroll
        for (int d0 = 0; d0 < 4; ++d0) { const bf16x8 kf = *(const LAS bf16x8*)(lds + L_KC + (2 * d0 + hh) * 512 + r32 * 16); p = __builtin_amdgcn_mfma_f32_32x32x16_bf16(kf, qr[d0], p, 0, 0, 0); }
        const int jlim = (tl == 63) ? c : c - 1;
        float mx = -INFINITY;
#pragma unroll
        for (int r = 0; r < 16; ++r) { if (crow(r, hh) > jlim) p[r] = -INFINITY; mx = fmaxf(mx, p[r]); }
        mx = swapmax(mx);
        const float mref = mx > -INFINITY ? mx : 0.f; float s = 0.f;
#pragma unroll
        for (int r = 0; r < 16; ++r) { p[r] = __builtin_amdgcn_exp2f(p[r] - mref); s += p[r]; }
        s = swapsum(s); const float inv = s > 0.f ? 1.0f / s : 0.f;
        LAS float* imp = (LAS float*)(lds + L_IMP);
#pragma unroll
        for (int r = 0; r < 16; ++r) { p[r] *= inv; imp[(hl * 32 + crow(r, hh)) * 64 + tl] = p[r]; }
        const bf16x8 pc0 = PK8(p, 0), pc1 = PK8(p, 8);
        f32x16 oc[2] = {};
        const LAS unsigned char* vb = lds + L_KC + 4096 + voff;
#pragma unroll
        for (int d0 = 0; d0 < 2; ++d0) { oc[d0] = __builtin_amdgcn_mfma_f32_32x32x16_bf16(vfrag(vb + (d0 * 2 + 0) * 1024), pc0, oc[d0], 0, 0, 0);
                                         oc[d0] = __builtin_amdgcn_mfma_f32_32x32x16_bf16(vfrag(vb + (d0 * 2 + 1) * 1024), pc1, oc[d0], 0, 0, 0); }
#pragma unroll
        for (int r = 0; r < 16; ++r) { ofin[0][r] = g_cmp * oc[0][r]; ofin[1][r] = g_cmp * oc[1][r]; }
    }
    __syncthreads();
    {
        const LAS float* imp = (const LAS float*)(lds + L_IMP);
        const unsigned negm = (c == 31) ? 0u : ~((2u << c) - 1u), forcem = 1u | (1u << c) | (c >= 1 ? (1u << (c - 1)) : 0u);
        float sc[32];
#pragma unroll
        for (int j = 0; j < 32; ++j) { const float v = (imp[(0 * 32 + j) * 64 + lane] + imp[(1 * 32 + j) * 64 + lane]) + (imp[(2 * 32 + j) * 64 + lane] + imp[(3 * 32 + j) * 64 + lane]);
            sc[j] = ((negm >> j) & 1u) ? -1e30f : ((forcem >> j) & 1u) ? 1e4f : v; }
        unsigned bits = 0u;
#pragma unroll
        for (int k = 0; k < 4; ++k) { const int jm = 4 * wid + k;
            const float v = (imp[(0 * 32 + jm) * 64 + lane] + imp[(1 * 32 + jm) * 64 + lane]) + (imp[(2 * 32 + jm) * 64 + lane] + imp[(3 * 32 + jm) * 64 + lane]);
            const float my = ((negm >> jm) & 1u) ? -1e30f : ((forcem >> jm) & 1u) ? 1e4f : v;
            int rank = 0;
#pragma unroll
            for (int j = 0; j < 32; ++j) rank += (sc[j] > my || (sc[j] == my && j < jm)) ? 1 : 0;
            if (rank < NSEL) bits |= 1u << jm; }
        if (bits) { atomicOr((unsigned*)(lds + L_SELM) + lane, bits); atomicOr((unsigned*)(lds + L_UNI), bits); }
    }
    __syncthreads();
    const unsigned mymask = ((const LAS unsigned*)(lds + L_SELM))[tl];
    const unsigned cmask = (c == 31) ? 0xffffffffu : ((2u << c) - 1u);
    const unsigned uni = (unsigned)__builtin_amdgcn_readfirstlane(*(const LAS unsigned*)(lds + L_UNI)) & cmask;
    run_branch<0>(lds, (const bf16*)(ws + WS_KS), n, g, uni, qr, c, tl, mymask, tid, r32, hh, voff, g_sel, ofin);
    __syncthreads();
    const unsigned wmask = cmask & ~((c >= 8) ? ((1u << (c - 8)) - 1u) : 0u);
    run_branch<1>(lds, (const bf16*)(ws + WS_KW), n, g, wmask, qr, c, tl, mymask, tid, r32, hh, voff, g_win, ofin);
    bf16* A2 = (bf16*)(ws + WS_A2) + (size_t)row * D + h * 64;
#pragma unroll
    for (int d0 = 0; d0 < 2; ++d0)
#pragma unroll
        for (int r4 = 0; r4 < 4; ++r4) { const int d = 32 * d0 + 8 * r4 + 4 * hh;
            *(GAS unsigned long long*)(A2 + d) = (unsigned long long)cvtpk(ofin[d0][4 * r4], ofin[d0][4 * r4 + 1]) | ((unsigned long long)cvtpk(ofin[d0][4 * r4 + 2], ofin[d0][4 * r4 + 3]) << 32); }
}
#undef PK8
}
__device__ __forceinline__ void attn_phase2(Frame& F, const KArgs& a) {
    { const int gt = F.vcu * (NWAVES * 64) + F.tid, NGT = F.G * NWAVES * 64; bf16* A2 = (bf16*)(a.ws + WS_A2);
      for (int i = gt; i < (M - MR) * (D / 8); i += NGT) *(GAS v4u*)(A2 + (size_t)MR * D + (size_t)i * 8) = (v4u){0u, 0u, 0u, 0u}; }
    for (int task = F.vcu; task < SB * NKV * SS; task += F.G) { const int n = task >> 3, g = (task >> 2) & 1, s = task & 3; sattn::task(F, a, n, g, s); }
    if (F.G == 256) { const int ng = F.vcu >> 3, s = F.vcu & 7;
#pragma unroll 1
        for (int i = 0; i < 4; ++i) { const int c = (i == 0) ? s : (i == 1) ? 15 - s : (i == 2) ? 16 + s : 31 - s; pattn::unit(F, a, ng >> 1, ng & 1, c); } }
    else { for (int u = F.vcu; u < NB * NKV * NBP; u += F.G) pattn::unit(F, a, u >> 6, (u >> 5) & 1, u & 31); }
}
#ifndef REP0
#define REP0 1
#endif
#ifndef REP3
#define REP3 1
#endif
#ifndef REP5
#define REP5 1
#endif
#ifndef REP6
#define REP6 1
#endif
#ifndef ATTN_PLACEHOLDER
#define ATTN_PLACEHOLDER 0
#endif
__global__ void __launch_bounds__(NWAVES * 64, 2) mk_fwd(KArgs args) {
    extern __shared__ __attribute__((aligned(16))) unsigned char lds[];
    Frame F;
    F.lds = (LAS unsigned char*)lds;
    F.MISC = (volatile LAS unsigned*)(F.lds + MISC_OFF);
    F.tid = threadIdx.x; F.lane = F.tid & 63; F.wave = __builtin_amdgcn_readfirstlane(F.tid >> 6);
    F.G = gridDim.x; { const int bx = blockIdx.x; F.vcu = (F.G % 8 == 0) ? (bx % 8) * (F.G / 8) + bx / 8 : bx; }
    unsigned char* ws = args.ws;
    F.ctl = (gu32*)(ws + WS_CTL);
    for (int u = F.tid; u < (LDS_BYTES - LDSCTL_OFF) / 4; u += NWAVES * 64) ((LAS unsigned*)(F.lds + LDSCTL_OFF))[u] = 0u;
    __syncthreads();
    XcdBarrier bar = xcd_barrier_post((unsigned*)(F.ctl + CW_BAR), F.MISC + 8);
    const int lo = args.ph_lo, hi = args.ph_hi;
#define IN(k) (lo <= (k) && (k) < hi)
#define GRID_BAR() xcd_barrier(bar)
    bf16* XB = (bf16*)(ws + WS_XB); bf16* HB = (bf16*)(ws + WS_H); float* V = (float*)(ws + WS_V); float* X1 = (float*)(ws + WS_X1); float* X2 = (float*)(ws + WS_X2);
    bf16* A2 = (bf16*)(ws + WS_A2);
    float* out = args.out;

    if (IN(0)) { for (int rep = 0; rep < REP0; ++rep) p0_prologue(F, args); GRID_BAR(); }
    if (IN(1)) { pg8::Gemm g{XB, (const bf16*)(ws + WS_WGUA), M, NGU, D}; pg8::StaticOrder S; S.init(M, NGU, F.G, (int)blockIdx.x);
        pg8::EpiSwiGLU E{HB}; pg8::gemm_phase<pg8::EpiSwiGLU, pg8::StaticOrder, true, true>(F.lds + RING_OFF, g, S, E); GRID_BAR(); }
    if (IN(2)) { pg8::Gemm g{HB, (const bf16*)(ws + WS_WDA), M, D, FF}; pg8::StaticOrder S; S.init(M, D, F.G, (int)blockIdx.x);
        pg8::EpiResPre E{(const float*)args.in[0], (const float*)args.in[1], V, ALPHA, 0.5f}; pg8::gemm_phase<pg8::EpiResPre, pg8::StaticOrder, true, true>(F.lds + RING_OFF, g, S, E); GRID_BAR(); }
    if (IN(3)) { for (int rep = 0; rep < REP3; ++rep) ln_phase(F, V, (const float*)args.in[10], (const float*)args.in[11], X1, X1 + (size_t)MP * D, XB); GRID_BAR(); }
    if (IN(4)) { pg8::Gemm g{XB, (const bf16*)(ws + WS_WIN), M, NINP, D}; pg8::StaticOrder S; S.init(M, NINP, F.G, (int)blockIdx.x);
        pg8::EpiInProj E{(const float*)(ws + WS_BIASP), (bf16*)(ws + WS_CB), (float*)(ws + WS_U), (bf16*)(ws + WS_Q), (bf16*)(ws + WS_KS), (bf16*)(ws + WS_KW), (float*)(ws + WS_G), out};
        pg8::gemm_phase<pg8::EpiInProj, pg8::StaticOrder, true, true>(F.lds + RING_OFF, g, S, E); GRID_BAR(); }
    if (IN(5)) { for (int rep = 0; rep < REP5; ++rep) {
        conv_phase(F, args);
#if !ATTN_PLACEHOLDER
#ifndef NO_COMPRESS
        compress_phase(F, args);
#endif
#endif
        }
        GRID_BAR(); }
    if (IN(6)) { for (int rep = 0; rep < REP6; ++rep) {
#if ATTN_PLACEHOLDER
        { const int gt = F.vcu * (NWAVES * 64) + F.tid, NGT = F.G * NWAVES * 64;
          for (int i = gt; i < M * (DA / 8); i += NGT) { const int m = i / (DA / 8), c = i % (DA / 8); *(GAS v4u*)(A2 + (size_t)m * D + c * 8) = (v4u){0u, 0u, 0u, 0u}; }
          for (int i = gt; i < (M - MR) * (DC / 8); i += NGT) { const int m = MR + i / (DC / 8), c = i % (DC / 8); *(GAS v4u*)(A2 + (size_t)m * D + DA + c * 8) = (v4u){0u, 0u, 0u, 0u}; } }
#else
#ifndef NO_ATTN
        attn_phase2(F, args);
#endif
#endif
        }
        GRID_BAR(); }
    if (IN(7)) { pg8::Gemm g{A2, (const bf16*)(ws + WS_WOUT), M, D, D}; pg8::StaticOrder S; S.init(M, D, F.G, (int)blockIdx.x);
        pg8::EpiResPre E{X1, X1 + (size_t)MP * D, V, ALPHA, 1.0f}; pg8::gemm_phase<pg8::EpiResPre, pg8::StaticOrder, true, true>(F.lds + RING_OFF, g, S, E); GRID_BAR(); }
    if (IN(8)) { ln_phase(F, V, (const float*)args.in[19], (const float*)args.in[20], X2, X2 + (size_t)MP * D, XB); GRID_BAR(); }
    if (IN(9)) { pg8::Gemm g{XB, (const bf16*)(ws + WS_WGUB), M, NGU, D}; pg8::StaticOrder S; S.init(M, NGU, F.G, (int)blockIdx.x);
        pg8::EpiSwiGLU E{HB}; pg8::gemm_phase<pg8::EpiSwiGLU, pg8::StaticOrder, true, true>(F.lds + RING_OFF, g, S, E); GRID_BAR(); }
    if (IN(10)) { pg8::Gemm g{HB, (const bf16*)(ws + WS_WDB), M, D, FF}; pg8::StaticOrder S; S.init(M, D, F.G, (int)blockIdx.x);
        pg8::EpiResPre E{X2, X2 + (size_t)MP * D, V, ALPHA, 0.5f}; pg8::gemm_phase<pg8::EpiResPre, pg8::StaticOrder, true, true>(F.lds + RING_OFF, g, S, E); GRID_BAR(); }
    if (IN(11)) { ln_phase(F, V, (const float*)args.in[24], (const float*)args.in[25], out + O_YP, out + O_YS, nullptr); }
#undef IN
#undef GRID_BAR
}

extern "C" void kernel_launch(void* const* d_in, const int* in_sizes, int n_in, void* d_out, int out_size, void* d_ws, size_t ws_size, hipStream_t stream) {
    static int grid = 0;
    if (grid == 0) {
        if (n_in != 26 || (size_t)out_size != O_END || ws_size < WS_END) { fprintf(stderr, "kernel_launch: unexpected shapes (n_in %d out %d ws %zu)\n", n_in, out_size, ws_size); grid = -1; return; }
        int dev = 0, cus = 0, per_cu = 0;
        if (hipGetDevice(&dev) != hipSuccess || hipDeviceGetAttribute(&cus, hipDeviceAttributeMultiprocessorCount, dev) != hipSuccess) { grid = -1; return; }
        if (hipFuncSetAttribute((const void*)mk_fwd, hipFuncAttributeMaxDynamicSharedMemorySize, LDS_BYTES) != hipSuccess) { fprintf(stderr, "kernel_launch: hipFuncSetAttribute failed\n"); grid = -1; return; }
        if (hipOccupancyMaxActiveBlocksPerMultiprocessor(&per_cu, (const void*)mk_fwd, NWAVES * 64, LDS_BYTES) != hipSuccess || per_cu < 1)
            fprintf(stderr, "kernel_launch: occupancy query reports %d workgroups per CU\n", per_cu);
        (void)hipGetLastError();
        grid = cus;
    }
    if (grid < 0) return;
    if (hipMemsetAsync((char*)d_ws + WS_CTL, 0, CTL_ZERO_BYTES, stream) != hipSuccess) return;
    KArgs a{};
    for (int i = 0; i < 26; ++i) a.in[i] = d_in[i];
    a.out = (float*)d_out; a.ws = (unsigned char*)d_ws; a.ph_lo = 0; a.ph_hi = 12;
    hipLaunchKernelGGL(mk_fwd, dim3(grid), dim3(NWAVES * 64), LDS_BYTES, stream, a);
}
```

```cpp
#include <hip/hip_runtime.h>
#include <cstdio>
#include <cstdint>
namespace pg8 {
#define PG8_LAS __attribute__((address_space(3)))
typedef unsigned short bf16_t;
typedef short bf16x8 __attribute__((ext_vector_type(8)));
typedef float f32x4 __attribute__((ext_vector_type(4)));
typedef unsigned u32x4 __attribute__((ext_vector_type(4)));
constexpr int BM = 256, BK = 64, HALF = 128, HTB = HALF * BK * 2  , STAGE_BYTES = 8 * HTB, NXCD = 8, WGM = 8;

__host__ __device__ __forceinline__ int lds_byte(int r, int c) { const int st = (r >> 4) * 2 + (c >> 5), rr = r & 15, cc = c & 31, ob = rr * 64 + cc * 2; return st * 1024 + (ob ^ (((ob >> 9) & 1) << 5)); }
__host__ __device__ __forceinline__ void stage_rc(int b, int& R, int& C) { const int st = b / 1024, sb = b % 1024, swz = sb ^ (((sb >> 9) & 1) << 5); R = (st >> 1) * 16 + swz / 64; C = (st & 1) * 32 + (swz % 64) / 2; }
__host__ __device__ __forceinline__ int perm32(int rho) { const int n = rho >> 4, i = rho & 15; return 8 * (i >> 2) + 4 * n + (i & 3); }

struct Unit { int pm, pn; };
struct Gemm { const bf16_t* A; const bf16_t* Bt; int M, N, K; };

struct StaticOrder {
    int nM, nN, nwg, G, c;
    __host__ __device__ void init(int M, int N, int G_, int c_) { nM = M / BM; nN = N / BM; nwg = nM * nN; G = G_; c = c_; }
    __host__ __device__ bool next(int i, Unit& u) const {
        const long L = (long)i * G + c; if (L >= nwg) return false;
        int wgid = (int)L; { const int q = nwg / NXCD, r = nwg % NXCD, xcd = wgid % NXCD, off = wgid / NXCD; wgid = (xcd < r ? xcd * (q + 1) : r * (q + 1) + (xcd - r) * q) + off; }
        const int nig = WGM * nN, gid = wgid / nig, fm = gid * WGM, gsz = (nM - fm) < WGM ? (nM - fm) : WGM;
        u.pm = fm + ((wgid % nig) % gsz); u.pn = (wgid % nig) / gsz; return true;
    }
    __device__ __forceinline__ void a_ready(const Unit&) const {}
    __device__ __forceinline__ void done(const Unit&) const {}
};

__device__ __forceinline__ unsigned cvt_pk_bf16(float lo, float hi) { unsigned r; asm volatile("v_cvt_pk_bf16_f32 %0, %1, %2" : "=v"(r) : "v"(lo), "v"(hi)); return r; }
typedef float f32x2 __attribute__((ext_vector_type(2)));
template <class Epi, class Sched, bool ALIGN_EPI = false, bool SP2 = false>
__device__ __forceinline__ void gemm_phase(PG8_LAS unsigned char* lds, const Gemm g, const Sched& S, const Epi& E) {
    const int tid = threadIdx.x, wid = __builtin_amdgcn_readfirstlane(tid >> 6), lane = tid & 63, wr = wid >> 2, wc = wid & 3, fr = lane & 15, fq = lane >> 4;
    const int K = g.K, nt = K / BK;
    unsigned voffA[2], voffB[2];
#pragma unroll
    for (int i = 0; i < 2; ++i) { int R, C; stage_rc(tid * 16 + i * 8192, R, C); const int Rb = Epi::PERM ? ((R & ~31) + perm32(R & 31)) : R;
        voffA[i] = (unsigned)(R * K + C) * 2u; voffB[i] = (unsigned)(Rb * K + C) * 2u; }
    const size_t kstep = (size_t)(BK * 2);
    const size_t hstep = (size_t)HALF * K * 2;
    const size_t tstep = 2 * hstep;
    const unsigned ldsw = (unsigned)wid * 1024u;
    const int aoff = lds_byte(wr * 64 + fr, fq * 8), boff = lds_byte(wc * 32 + fr, fq * 8);
#define PG8_SA(b, h) (((b) * 2 + (h)) * HTB)
#define PG8_SB(b, h) ((4 + (b) * 2 + (h)) * HTB)
#define PG8_STAGE(bufoff, gbase, voff) do { _Pragma("unroll") for (int _i = 0; _i < 2; ++_i) \
        __builtin_amdgcn_global_load_lds((const unsigned*)((const char*)(gbase) + (voff)[_i]), (PG8_LAS unsigned*)(lds + (bufoff) + ldsw + _i * 8192), 16, 0, 0); } while (0)
#define PG8_LDA(dst, b, h) do { _Pragma("unroll") for (int m = 0; m < 4; ++m) _Pragma("unroll") for (int k = 0; k < 2; ++k) dst[m][k] = *(const PG8_LAS bf16x8*)(lds + PG8_SA(b, h) + aoff + m * 2048 + k * 1024); } while (0)
#define PG8_LDB(dst, b, h) do { _Pragma("unroll") for (int n = 0; n < 2; ++n) _Pragma("unroll") for (int k = 0; k < 2; ++k) dst[n][k] = *(const PG8_LAS bf16x8*)(lds + PG8_SB(b, h) + boff + n * 2048 + k * 1024); } while (0)
#define PG8_MMA(ai, bj, At, Bt) do { __builtin_amdgcn_s_setprio(1); _Pragma("unroll") for (int m = 0; m < 4; ++m) _Pragma("unroll") for (int n = 0; n < 2; ++n) _Pragma("unroll") for (int k = 0; k < 2; ++k) \
        acc[ai][bj][m][n] = __builtin_amdgcn_mfma_f32_16x16x32_bf16(Bt[n][k], At[m][k], acc[ai][bj][m][n], 0, 0, 0); __builtin_amdgcn_s_setprio(0); } while (0)
#define PG8_WAIT_V(n) asm volatile("s_waitcnt vmcnt(" #n ")" ::: "memory")
#define PG8_WAIT_L(n) asm volatile("s_waitcnt lgkmcnt(" #n ")" ::: "memory")
#define PG8_BAR __builtin_amdgcn_s_barrier()
#define PG8_SCHED __builtin_amdgcn_sched_barrier(0)
    Unit cur, nxt; int ui = 0;
    if (!S.next(0, cur)) return;
    f32x4 acc[2][2][4][2];
#pragma unroll
    for (int a = 0; a < 2; ++a)
#pragma unroll
        for (int b = 0; b < 2; ++b)
#pragma unroll
            for (int m = 0; m < 4; ++m)
#pragma unroll
                for (int n = 0; n < 2; ++n) acc[a][b][m][n] = (f32x4){0.f, 0.f, 0.f, 0.f};
    bf16x8 At[4][2], B0[2][2], B1[2][2];
    const char* cA = (const char*)g.A + (size_t)cur.pm * tstep; const char* cB = (const char*)g.Bt + (size_t)cur.pn * tstep;
    S.a_ready(cur);
    if constexpr (SP2) {
        PG8_STAGE(PG8_SB(0, 0), cB, voffB); PG8_STAGE(PG8_SB(0, 1), cB + hstep, voffB); PG8_STAGE(PG8_SA(0, 0), cA, voffA); PG8_STAGE(PG8_SA(0, 1), cA + hstep, voffA);
        if (wr == 1) PG8_BAR;
        PG8_WAIT_V(2); PG8_BAR;
        PG8_STAGE(PG8_SB(1, 0), cB + kstep, voffB); PG8_STAGE(PG8_SA(1, 0), cA + kstep, voffA); PG8_STAGE(PG8_SB(1, 1), cB + hstep + kstep, voffB);
        PG8_WAIT_V(6); PG8_BAR;
    } else {
        PG8_STAGE(PG8_SB(0, 0), cB, voffB); PG8_STAGE(PG8_SA(0, 0), cA, voffA); PG8_STAGE(PG8_SB(0, 1), cB + hstep, voffB); PG8_STAGE(PG8_SA(0, 1), cA + hstep, voffA);
        if (wr == 1) PG8_BAR;
        PG8_WAIT_V(4); PG8_BAR;
        PG8_STAGE(PG8_SB(1, 0), cB + kstep, voffB); PG8_STAGE(PG8_SA(1, 0), cA + kstep, voffA); PG8_STAGE(PG8_SB(1, 1), cB + hstep + kstep, voffB);
        PG8_WAIT_V(6); PG8_BAR;
    }
    for (;;) {
        const bool has_next = S.next(ui + 1, nxt);
        const char* nA = has_next ? (const char*)g.A + (size_t)nxt.pm * tstep : cA; const char* nB = has_next ? (const char*)g.Bt + (size_t)nxt.pn * tstep : cB;
        for (int t = 0; t < nt; t += 2) {
            const bool last = (t == nt - 2);
            const char* a1 = cA + (size_t)(t + 1) * kstep;
            const char* a2 = last ? nA : cA + (size_t)(t + 2) * kstep; const char* b2 = last ? nB : cB + (size_t)(t + 2) * kstep;
            const char* a3 = a2 + kstep; const char* b3 = b2 + kstep;
            if (last && has_next) S.a_ready(nxt);
            if constexpr (SP2) {
            PG8_LDB(B0, 0, 0); PG8_LDB(B1, 0, 1); PG8_SCHED; PG8_LDA(At, 0, 0); PG8_STAGE(PG8_SA(1, 1), a1 + hstep, voffA);
            PG8_WAIT_V(8); PG8_WAIT_L(0); PG8_BAR; PG8_MMA(0, 0, At, B0); PG8_MMA(0, 1, At, B1); PG8_BAR; PG8_SCHED;
            PG8_LDA(At, 0, 1); PG8_STAGE(PG8_SB(0, 0), b2, voffB); PG8_STAGE(PG8_SB(0, 1), b2 + hstep, voffB); PG8_STAGE(PG8_SA(0, 0), a2, voffA);
            PG8_WAIT_V(8); PG8_WAIT_L(0); PG8_BAR; PG8_MMA(1, 0, At, B0); PG8_MMA(1, 1, At, B1); PG8_BAR; PG8_SCHED;
            PG8_LDB(B0, 1, 0); PG8_LDB(B1, 1, 1); PG8_SCHED; PG8_LDA(At, 1, 0); PG8_STAGE(PG8_SA(0, 1), a2 + hstep, voffA);
            PG8_WAIT_V(8); PG8_WAIT_L(0); PG8_BAR; PG8_MMA(0, 0, At, B0); PG8_MMA(0, 1, At, B1); PG8_BAR; PG8_SCHED;
            PG8_LDA(At, 1, 1); PG8_STAGE(PG8_SB(1, 0), b3, voffB); PG8_STAGE(PG8_SB(1, 1), b3 + hstep, voffB); PG8_STAGE(PG8_SA(1, 0), a3, voffA);
            PG8_WAIT_V(8); PG8_WAIT_L(0); PG8_BAR; PG8_MMA(1, 0, At, B0); PG8_MMA(1, 1, At, B1); PG8_BAR; PG8_SCHED;
            } else {
            PG8_LDB(B0, 0, 0); PG8_SCHED; PG8_LDA(At, 0, 0); PG8_STAGE(PG8_SA(1, 1), a1 + hstep, voffA);
            PG8_WAIT_L(8); PG8_BAR; PG8_WAIT_L(0); PG8_MMA(0, 0, At, B0); PG8_BAR; PG8_SCHED;
            PG8_LDB(B1, 0, 1); PG8_STAGE(PG8_SB(0, 0), b2, voffB);
            PG8_BAR; PG8_WAIT_L(0); PG8_MMA(0, 1, At, B1); PG8_BAR;
            PG8_LDA(At, 0, 1); PG8_STAGE(PG8_SA(0, 0), a2, voffA);
            PG8_BAR; PG8_WAIT_L(0); PG8_MMA(1, 0, At, B0); PG8_BAR; PG8_SCHED;
            PG8_STAGE(PG8_SB(0, 1), b2 + hstep, voffB);
            PG8_WAIT_V(6); PG8_BAR; PG8_MMA(1, 1, At, B1); PG8_BAR;
            PG8_LDB(B0, 1, 0); PG8_SCHED; PG8_LDA(At, 1, 0); PG8_STAGE(PG8_SA(0, 1), a2 + hstep, voffA);
            PG8_WAIT_L(8); PG8_BAR; PG8_WAIT_L(0); PG8_MMA(0, 0, At, B0); PG8_BAR; PG8_SCHED;
            PG8_LDB(B1, 1, 1); PG8_STAGE(PG8_SB(1, 0), b3, voffB);
            PG8_BAR; PG8_WAIT_L(0); PG8_MMA(0, 1, At, B1); PG8_BAR;
            PG8_LDA(At, 1, 1); PG8_STAGE(PG8_SA(1, 0), a3, voffA);
            PG8_BAR; PG8_WAIT_L(0); PG8_MMA(1, 0, At, B0); PG8_BAR; PG8_SCHED;
            PG8_STAGE(PG8_SB(1, 1), b3 + hstep, voffB);
            PG8_WAIT_V(6); PG8_BAR; PG8_MMA(1, 1, At, B1); PG8_BAR;
            }
        }
        if constexpr (ALIGN_EPI) { if (wr == 0) PG8_BAR; }
        if constexpr (!Epi::AFTER_DRAIN) { E(acc, cur, wr, wc, fr, fq); S.done(cur); }
        if (!has_next) break;
#pragma unroll
        for (int a = 0; a < 2; ++a)
#pragma unroll
            for (int b = 0; b < 2; ++b)
#pragma unroll
                for (int m = 0; m < 4; ++m)
#pragma unroll
                    for (int n = 0; n < 2; ++n) acc[a][b][m][n] = (f32x4){0.f, 0.f, 0.f, 0.f};
        cur = nxt; cA = nA; cB = nB; ++ui;
        if constexpr (ALIGN_EPI) { if (wr == 1) PG8_BAR; }
    }
    PG8_WAIT_V(0);
    if constexpr (!ALIGN_EPI) { if (wr == 0) PG8_BAR; }
    PG8_BAR;
    if constexpr (Epi::AFTER_DRAIN) { E.fused(acc, cur, wr, wc, fr, fq, lds, wid, lane); S.done(cur); }
#undef PG8_SA
#undef PG8_SB
#undef PG8_STAGE
#undef PG8_LDA
#undef PG8_LDB
#undef PG8_MMA
#undef PG8_WAIT_V
#undef PG8_WAIT_L
#undef PG8_BAR
#undef PG8_SCHED
}
}
constexpr int NWAVES = 8;
constexpr int D = 1024, FF = 2816, NGU = 2 * FF, NINP = 3072, DIN = 2840;
constexpr int NB = 16, T = 2048, MP = NB * T, SB = 32, SS = 4, MS = SB * SS, MR = MP + MS, M = 33024;
constexpr int DC = 512, DA = 512, HD = 64, NH = 8, NKV = 2, KVW = 256;
constexpr int PAST = 16384, PAGE = 128, NPAGES = PAST / PAGE, BLK = 64, NSEL = 16, WIN = 512;
constexpr int NBP = T / BLK  , NBS = PAST / BLK  ;
constexpr float ALPHA = 1.189207115002721f, LN_EPS = 1e-5f;
constexpr float QSCALE = 0.125f * 1.4426950408889634f;
constexpr size_t O_YP = 0, O_YS = (size_t)MP * D, O_PCMP = O_YS + (size_t)MS * D, O_PSEL = O_PCMP + (size_t)MP * KVW, O_PWIN = O_PSEL + (size_t)MP * KVW,
                 O_PCONV = O_PWIN + (size_t)NB * WIN * KVW, O_SCMP = O_PCONV + (size_t)NB * 2 * DC, O_SSEL = O_SCMP + (size_t)MS * KVW, O_SWIN = O_SSEL + (size_t)MS * KVW,
                 O_SCONV = O_SWIN + (size_t)SB * WIN * KVW, O_END = O_SCONV + (size_t)SB * 2 * DC;
static_assert(O_END == 56868864, "output size");
constexpr size_t MiB = 1u << 20;
constexpr size_t WS_CTL = 0, CTL_ZERO_BYTES = 1 * MiB;
constexpr size_t WS_WGUA = 2 * MiB, WS_WDA = 14 * MiB, WS_WIN = 20 * MiB, WS_WOUT = 26 * MiB, WS_WGUB = 28 * MiB, WS_WDB = 40 * MiB, WS_W1T = 46 * MiB, WS_BIASP = 47 * MiB;
constexpr size_t WS_KC = 48 * MiB;
constexpr size_t WS_XB = 64 * MiB;
constexpr size_t WS_H = 130 * MiB;
constexpr size_t WS_V = 308 * MiB;
constexpr size_t WS_X1 = 438 * MiB, WS_X2 = 568 * MiB;
constexpr size_t WS_CB = 698 * MiB;
constexpr size_t WS_U = 731 * MiB;
constexpr size_t WS_Q = 796 * MiB;
constexpr size_t WS_KS = 829 * MiB, WS_KW = 846 * MiB;
constexpr size_t WS_G = 863 * MiB;
constexpr size_t WS_A2 = 868 * MiB;
constexpr size_t WS_SELM = 933 * MiB;
constexpr size_t WS_END = 940 * MiB;
constexpr int CW_TMO = 0, CW_CODE = 1, CW_BAR = 4096;
constexpr int RING_OFF = 0, RING_BYTES = 131072;
constexpr int LDSCTL_OFF = RING_BYTES, MISC_OFF = LDSCTL_OFF + 320;
constexpr int LDS_BYTES = 147456;
namespace pg8 {
typedef unsigned u32x2 __attribute__((ext_vector_type(2)));
__device__ __forceinline__ float silu_mul(float g, float u) { return g * u * __builtin_amdgcn_rcpf(1.0f + __builtin_amdgcn_exp2f(-1.4426950408889634f * g)); }
struct EpiSwiGLU {
    static constexpr bool PERM = true, AFTER_DRAIN = false;
    bf16_t* H;
    __device__ __forceinline__ void operator()(const f32x4 (&acc)[2][2][4][2], const Unit& u, int wr, int wc, int fr, int fq) const {
        const int row0 = u.pm * BM + wr * 64 + fr, col0 = u.pn * HALF + wc * 32 + 8 * fq;
#pragma unroll
        for (int ai = 0; ai < 2; ++ai)
#pragma unroll
            for (int m = 0; m < 4; ++m) {
                const f32x4 g0 = acc[ai][0][m][0], g1 = acc[ai][0][m][1], u0 = acc[ai][1][m][0], u1 = acc[ai][1][m][1];
                u32x4 w;
                w.x = cvt_pk_bf16(silu_mul(g0[0], u0[0]), silu_mul(g0[1], u0[1])); w.y = cvt_pk_bf16(silu_mul(g0[2], u0[2]), silu_mul(g0[3], u0[3]));
                w.z = cvt_pk_bf16(silu_mul(g1[0], u1[0]), silu_mul(g1[1], u1[1])); w.w = cvt_pk_bf16(silu_mul(g1[2], u1[2]), silu_mul(g1[3], u1[3]));
                *(u32x4*)(H + (size_t)(row0 + ai * HALF + m * 16) * FF + col0) = w;
            }
    }
};
struct EpiResPre {
    static constexpr bool PERM = false, AFTER_DRAIN = false;
    const float* base_p; const float* base_s; float* V; float alpha, s;
    __device__ __forceinline__ void operator()(const f32x4 (&acc)[2][2][4][2], const Unit& u, int wr, int wc, int fr, int fq) const {
        const int col0 = u.pn * BM + wc * 32 + 4 * fq;
        const bool sp = (u.pm == MP / BM);
#pragma unroll
        for (int ai = 0; ai < 2; ++ai) {
            if (sp && ai == 1) continue;
#pragma unroll
            for (int m = 0; m < 4; ++m) {
                const int r = u.pm * BM + ai * HALF + wr * 64 + m * 16 + fr;
                const float* brow = sp ? base_s + (size_t)(r - MP) * D : base_p + (size_t)r * D;
                float* vrow = V + (size_t)r * D;
#pragma unroll
                for (int bj = 0; bj < 2; ++bj)
#pragma unroll
                    for (int n = 0; n < 2; ++n) { const int c = col0 + bj * HALF + n * 16; const f32x4 x = *(const f32x4*)(brow + c);
                        *(f32x4*)(vrow + c) = x * alpha + acc[ai][bj][m][n] * s; }
            }
        }
    }
};
struct EpiInProj {
    static constexpr bool PERM = false, AFTER_DRAIN = false;
    const float* biasp; bf16_t* CB; float* U; bf16_t* Q; bf16_t* KS; bf16_t* KW; float* G; float* out;
    __device__ __forceinline__ void operator()(const f32x4 (&acc)[2][2][4][2], const Unit& u, int wr, int wc, int fr, int fq) const {
        const int pn = u.pn; const bool sp = (u.pm == MP / BM);
        const int cl = wc * 32 + 4 * fq;
        f32x4 bv[2][2];
#pragma unroll
        for (int bj = 0; bj < 2; ++bj)
#pragma unroll
            for (int n = 0; n < 2; ++n) bv[bj][n] = *(const f32x4*)(biasp + pn * BM + bj * HALF + cl + n * 16);
#pragma unroll
        for (int ai = 0; ai < 2; ++ai) {
            if (sp && ai == 1) continue;
#pragma unroll
            for (int m = 0; m < 4; ++m) {
                const int r = u.pm * BM + ai * HALF + wr * 64 + m * 16 + fr;
                const int si = r - MP;
                const int tb = r & (T - 1), nb = r >> 11;
                if (pn < 2) {
#pragma unroll
                    for (int bj = 0; bj < 2; ++bj)
#pragma unroll
                        for (int n = 0; n < 2; ++n) { const f32x4 v = acc[ai][bj][m][n] + bv[bj][n]; u32x2 w; w.x = cvt_pk_bf16(v[0], v[1]); w.y = cvt_pk_bf16(v[2], v[3]);
                            *(u32x2*)(CB + (size_t)r * DC + pn * BM + bj * HALF + cl + n * 16) = w; }
                } else if (pn < 6) {
#pragma unroll
                    for (int n = 0; n < 2; ++n) { const f32x4 v = (acc[ai][0][m][n] + bv[0][n]) * (acc[ai][1][m][n] + bv[1][n]); const int ch = (pn - 2) * HALF + cl + n * 16;
                        *(f32x4*)(U + (size_t)r * DC + ch) = v;
                        if (!sp) { if (tb >= T - 2) *(f32x4*)(out + O_PCONV + (size_t)(nb * 2 + (tb - (T - 2))) * DC + ch) = v; }
                        else { const int s = si & 3; if (s >= 2) *(f32x4*)(out + O_SCONV + (size_t)((si >> 2) * 2 + (s - 2)) * DC + ch) = v; } }
                } else if (pn < 8) {
#pragma unroll
                    for (int bj = 0; bj < 2; ++bj)
#pragma unroll
                        for (int n = 0; n < 2; ++n) { const f32x4 v = (acc[ai][bj][m][n] + bv[bj][n]) * QSCALE; u32x2 w; w.x = cvt_pk_bf16(v[0], v[1]); w.y = cvt_pk_bf16(v[2], v[3]);
                            *(u32x2*)(Q + (size_t)r * DA + (pn - 6) * BM + bj * HALF + cl + n * 16) = w; }
                } else if (pn == 8) {
                    float* o = sp ? out + O_SCMP + (size_t)si * KVW : out + O_PCMP + (size_t)r * KVW;
#pragma unroll
                    for (int bj = 0; bj < 2; ++bj)
#pragma unroll
                        for (int n = 0; n < 2; ++n) *(f32x4*)(o + bj * HALF + cl + n * 16) = acc[ai][bj][m][n] + bv[bj][n];
                } else if (pn == 9) {
                    float* o = sp ? out + O_SSEL + (size_t)si * KVW : out + O_PSEL + (size_t)r * KVW;
#pragma unroll
                    for (int bj = 0; bj < 2; ++bj)
#pragma unroll
                        for (int n = 0; n < 2; ++n) { const f32x4 v = acc[ai][bj][m][n] + bv[bj][n]; *(f32x4*)(o + bj * HALF + cl + n * 16) = v;
                            u32x2 w; w.x = cvt_pk_bf16(v[0], v[1]); w.y = cvt_pk_bf16(v[2], v[3]); *(u32x2*)(KS + (size_t)r * KVW + bj * HALF + cl + n * 16) = w; }
                } else if (pn == 10) {
                    float* o = nullptr;
                    if (sp) o = out + O_SWIN + (size_t)((si >> 2) * WIN + (WIN - SS) + (si & 3)) * KVW;
                    else if (tb >= T - WIN) o = out + O_PWIN + (size_t)(nb * WIN + tb - (T - WIN)) * KVW;
#pragma unroll
                    for (int bj = 0; bj < 2; ++bj)
#pragma unroll
                        for (int n = 0; n < 2; ++n) { const f32x4 v = acc[ai][bj][m][n] + bv[bj][n]; if (o) *(f32x4*)(o + bj * HALF + cl + n * 16) = v;
                            u32x2 w; w.x = cvt_pk_bf16(v[0], v[1]); w.y = cvt_pk_bf16(v[2], v[3]); *(u32x2*)(KW + (size_t)r * KVW + bj * HALF + cl + n * 16) = w; }
                } else {
                    if (wc == 0) {
#pragma unroll
                        for (int n = 0; n < 2; ++n) { if (n == 1 && fq >= 2) continue; f32x4 v = acc[ai][0][m][n] + bv[0][n];
#pragma unroll
                            for (int j = 0; j < 4; ++j) v[j] = __builtin_amdgcn_rcpf(1.0f + __builtin_amdgcn_exp2f(-1.4426950408889634f * v[j]));
                            *(f32x4*)(G + (size_t)r * 32 + cl + n * 16) = v; }
                    }
                }
            }
        }
    }
};
}
#define GAS __attribute__((address_space(1)))
#define LAS __attribute__((address_space(3)))
typedef unsigned short bf16;
typedef unsigned v4u __attribute__((ext_vector_type(4)));
typedef float f32x4 __attribute__((ext_vector_type(4)));
typedef short bf16x8 __attribute__((ext_vector_type(8)));
typedef GAS unsigned gu32;
typedef GAS unsigned long long gu64;
#define RLX_AGENT __ATOMIC_RELAXED, __HIP_MEMORY_SCOPE_AGENT
#define LDS_WAIT() asm volatile("s_waitcnt lgkmcnt(0)" ::: "memory")
#define VM_WAIT() asm volatile("s_waitcnt vmcnt(0)" ::: "memory")
__device__ __forceinline__ unsigned long long rt() { return __builtin_amdgcn_s_memrealtime(); }
__device__ __forceinline__ unsigned f2bf(float f) { unsigned u = __builtin_bit_cast(unsigned, f); return (u + 0x7fffu + ((u >> 16) & 1u)) >> 16; }
__device__ __forceinline__ unsigned pk2(float lo, float hi) { return f2bf(lo) | (f2bf(hi) << 16); }
#define XB_TMO      128
#define XB_XCNT(j)  (256  + 64 * (j))
#define XB_XSUB(j)  (1280 + 64 * (j))
#define XB_XGEN(j)  (2304 + 64 * (j))
#define XB_TOP      3328
#define XB_TOPGEN   3392
#define XCD_BAR_WORDS 3456
#define XB_SPIN_CAP (1u << 18)

__device__ __forceinline__ unsigned xb_ld(unsigned* p)              { return __hip_atomic_load(p, __ATOMIC_RELAXED, __HIP_MEMORY_SCOPE_AGENT); }
__device__ __forceinline__ unsigned xb_add(unsigned* p, unsigned v) { return __hip_atomic_fetch_add(p, v, __ATOMIC_RELAXED, __HIP_MEMORY_SCOPE_AGENT); }
__device__ __forceinline__ unsigned xb_xcc_id() { return (unsigned)__builtin_amdgcn_s_getreg((3 << 11) | 20) & 0xFu; }
#define XB_SPIN(cond, bar) do { unsigned _sp = 0; while (cond) { __builtin_amdgcn_s_sleep(1); \
    if ((++_sp & 255u) == 0u) { if (xb_ld(&(bar)[XB_TMO])) break; if (_sp > XB_SPIN_CAP) { atomicAdd(&(bar)[XB_TMO], 1u); break; } } } } while (0)

struct XcdBarrier {
    unsigned* bar; unsigned x;
    volatile LAS unsigned* st;
};

__device__ __forceinline__ XcdBarrier xcd_barrier_post(unsigned* bar, volatile LAS unsigned* st) {
    XcdBarrier b; b.bar = bar; b.x = xb_xcc_id(); b.st = st;
    if (threadIdx.x == 0) (void)xb_add(&bar[XB_XCNT(b.x)], 1u);
    return b;
}
__device__ __forceinline__ void xcd_barrier_complete(unsigned* bar, unsigned x, unsigned& nloc, unsigned& nx) {
    const unsigned G = gridDim.x * gridDim.y * gridDim.z;
    unsigned sum, cnt, mine, sp = 0u;
    for (;;) {
        sum = 0u; cnt = 0u; mine = 0u;
#pragma unroll
        for (unsigned j = 0; j < 16; ++j) { const unsigned c = xb_ld(&bar[XB_XCNT(j)]); sum += c; cnt += (c > 0u) ? 1u : 0u; mine = (j == x) ? c : mine; }
        if (sum == G) break;
        __builtin_amdgcn_s_sleep(1);
        if ((++sp & 255u) == 0u) { if (xb_ld(&bar[XB_TMO])) break; if (sp > XB_SPIN_CAP) { atomicAdd(&bar[XB_TMO], 1u); break; } }
    }
    nloc = mine > 0u ? mine : 1u; nx = cnt > 0u ? cnt : 1u;
}

__device__ __forceinline__ void xcd_barrier(const XcdBarrier& b) {
    asm volatile("s_waitcnt vmcnt(0)" ::: "memory");
    __syncthreads();
    if (threadIdx.x == 0) {
        unsigned* bar = b.bar;
        __builtin_amdgcn_s_waitcnt(0);
        unsigned nloc = b.st[0], nx = b.st[1];
        if (nloc == 0u) { xcd_barrier_complete(bar, b.x, nloc, nx); b.st[0] = nloc; b.st[1] = nx; }
        const unsigned old = xb_add(&bar[XB_XSUB(b.x)], 1u);
        const unsigned gen = old / nloc;
        if (old + 1u == (gen + 1u) * nloc) {
            __builtin_amdgcn_fence(__ATOMIC_RELEASE, "agent");
            asm volatile("s_waitcnt vmcnt(0)" ::: "memory");
            const unsigned og = xb_add(&bar[XB_TOP], 1u);
            const unsigned tg = og / nx;
            if (og + 1u == (tg + 1u) * nx) xb_add(&bar[XB_TOPGEN], 1u);
            else XB_SPIN(xb_ld(&bar[XB_TOPGEN]) == tg, bar);
            __builtin_amdgcn_fence(__ATOMIC_ACQUIRE, "agent");
            xb_add(&bar[XB_XGEN(b.x)], 1u);
            asm volatile("s_waitcnt vmcnt(0)" ::: "memory");
        } else {
            XB_SPIN(xb_ld(&bar[XB_XGEN(b.x)]) == gen, bar);
            __builtin_amdgcn_fence(__ATOMIC_ACQUIRE, "agent");
            asm volatile("s_waitcnt vmcnt(0)" ::: "memory");
        }
    }
    __syncthreads();
}
struct Frame {
    LAS unsigned char* lds;
    volatile LAS unsigned* MISC;
    gu32* ctl;
    int tid, lane, wave;
    int vcu, G;
};
__device__ __forceinline__ float wave_sum(float v) {
#pragma unroll
    for (int o = 1; o < 64; o <<= 1) v += __shfl_xor(v, o);
    return v;
}
__device__ __forceinline__ float wave_max(float v) {
#pragma unroll
    for (int o = 1; o < 64; o <<= 1) v = fmaxf(v, __shfl_xor(v, o));
    return v;
}
__device__ __forceinline__ void p0_transpose_item(const float* W, int K, int N, bf16* WT, int dst_row0, int k0, int n0, int nvalid, LAS float* scr, int lane) {
#pragma unroll 8
    for (int i = 0; i < 32; ++i) { const int kk = 2 * i + (lane >> 5); const int n = lane & 31; scr[kk * 33 + n] = (n < nvalid) ? W[(size_t)(k0 + kk) * N + n0 + n] : 0.f; }
    LDS_WAIT(); asm volatile("" ::: "memory");
    const int c = lane & 7;
#pragma unroll
    for (int j = 0; j < 4; ++j) { const int n = (lane >> 3) + 8 * j; const LAS float* s = scr + (8 * c) * 33 + n;
        v4u o; o.x = pk2(s[0 * 33], s[1 * 33]); o.y = pk2(s[2 * 33], s[3 * 33]); o.z = pk2(s[4 * 33], s[5 * 33]); o.w = pk2(s[6 * 33], s[7 * 33]);
        *(GAS v4u*)(WT + (size_t)(dst_row0 + n) * K + k0 + 8 * c) = o; }
    LDS_WAIT(); asm volatile("" ::: "memory");
}
__device__ __forceinline__ int map_gu(int n0, int up) { return 256 * (n0 >> 7) + (n0 & 127) + (up ? 128 : 0); }
__device__ __forceinline__ int map_in(int n0) {
    if (n0 < 512) return n0;
    if (n0 < 1024) { const int ch = n0 - 512; return 512 + 256 * (ch >> 7) + (ch & 127); }
    if (n0 < 1536) { const int ch = n0 - 1024; return 512 + 256 * (ch >> 7) + 128 + (ch & 127); }
    return n0;
}
__device__ __forceinline__ int unmap_in(int r) {
    if (r < 512) return r;
    if (r < 1536) { const int t = (r - 512) >> 8, w = (r - 512) & 255; return w < 128 ? 512 + 128 * t + w : 1024 + 128 * t + (w - 128); }
    if (r < DIN) return r;
    return -1;
}
struct KArgs { const void* in[26]; float* out; unsigned char* ws; int ph_lo, ph_hi; };
__device__ __forceinline__ void p0_prologue(Frame& F, const KArgs& a) {
    LAS float* scr = (LAS float*)(F.lds + RING_OFF + F.wave * 16384);
    const int gw = F.vcu * NWAVES + F.wave, NGW = F.G * NWAVES;
    unsigned char* ws = a.ws;
    constexpr int I_GU = (D / 64) * (FF / 32), I_DN = (FF / 64) * (D / 32), I_IN = (D / 64) * ((DIN + 31) / 32), I_OUT = (D / 64) * (D / 32), I_W1 = (4096 / 64) * (64 / 32);
    constexpr int NITEMS = 4 * I_GU + 2 * I_DN + I_IN + I_OUT + 2 * I_W1;
    for (int it = gw; it < NITEMS; it += NGW) {
        int r = it;
        if (r < 4 * I_GU) { const int which = r / I_GU; r -= which * I_GU;
            const float* W = (const float*)a.in[which == 0 ? 7 : which == 1 ? 8 : which == 2 ? 21 : 22]; bf16* WT = (bf16*)(ws + (which < 2 ? WS_WGUA : WS_WGUB));
            const int nblk = FF / 32, kb = r / nblk, nb = r % nblk; p0_transpose_item(W, D, FF, WT, map_gu(32 * nb, which & 1), 64 * kb, 32 * nb, 32, scr, F.lane); continue; }
        r -= 4 * I_GU;
        if (r < 2 * I_DN) { const int which = r / I_DN; r -= which * I_DN;
            const float* W = (const float*)a.in[which == 0 ? 9 : 23]; bf16* WT = (bf16*)(ws + (which == 0 ? WS_WDA : WS_WDB));
            const int nblk = D / 32, kb = r / nblk, nb = r % nblk; p0_transpose_item(W, FF, D, WT, 32 * nb, 64 * kb, 32 * nb, 32, scr, F.lane); continue; }
        r -= 2 * I_DN;
        if (r < I_IN) { const int nblk = (DIN + 31) / 32, kb = r / nblk, nb = r % nblk; const int nv = (DIN - 32 * nb) < 32 ? (DIN - 32 * nb) : 32;
            p0_transpose_item((const float*)a.in[12], D, DIN, (bf16*)(ws + WS_WIN), map_in(32 * nb), 64 * kb, 32 * nb, nv, scr, F.lane); continue; }
        r -= I_IN;
        if (r < I_OUT) { const int nblk = D / 32, kb = r / nblk, nb = r % nblk; p0_transpose_item((const float*)a.in[18], D, D, (bf16*)(ws + WS_WOUT), 32 * nb, 64 * kb, 32 * nb, 32, scr, F.lane); continue; }
        r -= I_OUT;
        { const int c = r / I_W1; r -= c * I_W1; const int kb = r / 2, nb = r % 2;
          p0_transpose_item((const float*)a.in[15] + (size_t)c * 4096 * 64, 4096, 64, (bf16*)(ws + WS_W1T) + (size_t)c * 64 * 4096, 32 * nb, 64 * kb, 32 * nb, 32, scr, F.lane); }
    }
    { const int gt = F.vcu * (NWAVES * 64) + F.tid, NGT = F.G * NWAVES * 64;
      for (int i = gt; i < NINP; i += NGT) { const int s = unmap_in(i); ((float*)(ws + WS_BIASP))[i] = s >= 0 ? ((const float*)a.in[13])[s] : 0.f; }
      constexpr int ZR0 = ((DIN + 31) / 32) * 32; GAS v4u* z = (GAS v4u*)((bf16*)(ws + WS_WIN) + (size_t)ZR0 * D);
      for (int i = gt; i < (NINP - ZR0) * D / 8; i += NGT) z[i] = (v4u){0u, 0u, 0u, 0u};
      const GAS f32x4* sw = (const GAS f32x4*)a.in[4]; GAS f32x4* so = (GAS f32x4*)(a.out + O_SWIN);
      for (int i = gt; i < SB * (WIN - SS) * (KVW / 4); i += NGT) { const int n = i / ((WIN - SS) * (KVW / 4)), rem = i % ((WIN - SS) * (KVW / 4));
          so[(size_t)n * WIN * (KVW / 4) + rem] = sw[(size_t)n * WIN * (KVW / 4) + SS * (KVW / 4) + rem]; }
    }
    for (int m = gw; m < M; m += NGW) {
        GAS unsigned long long* o8 = (GAS unsigned long long*)((bf16*)(ws + WS_XB) + (size_t)m * D) + F.lane;
        if (m >= MR) {
#pragma unroll
            for (int j = 0; j < 4; ++j) o8[64 * j] = 0ull;
            continue; }
        const float* xrow = m < MP ? (const float*)a.in[0] + (size_t)m * D : (const float*)a.in[1] + (size_t)(m - MP) * D;
        const GAS f32x4* xr = (const GAS f32x4*)xrow + F.lane;
#pragma unroll
        for (int j = 0; j < 4; ++j) { const f32x4 v = xr[64 * j]; o8[64 * j] = (unsigned long long)pk2(v.x, v.y) | ((unsigned long long)pk2(v.z, v.w) << 32); }
    }
}
__device__ __forceinline__ void ln_phase(Frame& F, const float* V, const float* gam, const float* bet, float* of_p, float* of_s, bf16* XB) {
    const int gw = F.vcu * NWAVES + F.wave, NGW = F.G * NWAVES;
    f32x4 g4[4], b4[4];
#pragma unroll
    for (int j = 0; j < 4; ++j) { g4[j] = ((const GAS f32x4*)gam)[F.lane + 64 * j]; b4[j] = ((const GAS f32x4*)bet)[F.lane + 64 * j]; }
    for (int m = gw; m < M; m += NGW) {
        if (m >= MR) { if (XB) { GAS unsigned long long* o8 = (GAS unsigned long long*)(XB + (size_t)m * D) + F.lane;
#pragma unroll
                for (int j = 0; j < 4; ++j) o8[64 * j] = 0ull; }
            continue; }
        const GAS f32x4* xr = (const GAS f32x4*)(V + (size_t)m * D) + F.lane;
        f32x4 v[4]; float s = 0.f;
#pragma unroll
        for (int j = 0; j < 4; ++j) { v[j] = xr[64 * j]; s += (v[j].x + v[j].y) + (v[j].z + v[j].w); }
        const float mean = wave_sum(s) * (1.f / D); float s2 = 0.f;
#pragma unroll
        for (int j = 0; j < 4; ++j) { v[j] = v[j] - mean; s2 += (v[j].x * v[j].x + v[j].y * v[j].y) + (v[j].z * v[j].z + v[j].w * v[j].w); }
        const float rstd = 1.f / sqrtf(wave_sum(s2) * (1.f / D) + LN_EPS);
        float* orow = m < MP ? of_p + (size_t)m * D : of_s + (size_t)(m - MP) * D;
        GAS f32x4* of = (GAS f32x4*)orow + F.lane;
#pragma unroll
        for (int j = 0; j < 4; ++j) { v[j] = v[j] * rstd * g4[j] + b4[j]; of[64 * j] = v[j]; }
        if (XB) { GAS unsigned long long* o8 = (GAS unsigned long long*)(XB + (size_t)m * D) + F.lane;
#pragma unroll
            for (int j = 0; j < 4; ++j) o8[64 * j] = (unsigned long long)pk2(v[j].x, v[j].y) | ((unsigned long long)pk2(v[j].z, v[j].w) << 32); }
    }
}
__device__ __forceinline__ void conv_phase(Frame& F, const KArgs& a) {
    const int gw = F.vcu * NWAVES + F.wave, NGW = F.G * NWAVES;
    const float* U = (const float*)(a.ws + WS_U); const bf16* CB = (const bf16*)(a.ws + WS_CB); bf16* A2 = (bf16*)(a.ws + WS_A2);
    const float* wc = (const float*)a.in[14]; const float* sc = (const float*)a.in[5];
    f32x4 w0[2], w1[2], w2[2];
#pragma unroll
    for (int j = 0; j < 2; ++j) { const int ch = 4 * F.lane + 256 * j; w0[j] = *(const GAS f32x4*)(wc + ch); w1[j] = *(const GAS f32x4*)(wc + DC + ch); w2[j] = *(const GAS f32x4*)(wc + 2 * DC + ch); }
    for (int m = gw; m < MR; m += NGW) {
#pragma unroll
        for (int j = 0; j < 2; ++j) {
            const int ch = 4 * F.lane + 256 * j;
            const f32x4 uc = *(const GAS f32x4*)(U + (size_t)m * DC + ch);
            f32x4 u1, u2;
            if (m < MP) { const int t = m & (T - 1);
                u1 = t >= 1 ? *(const GAS f32x4*)(U + (size_t)(m - 1) * DC + ch) : (f32x4){0.f, 0.f, 0.f, 0.f};
                u2 = t >= 2 ? *(const GAS f32x4*)(U + (size_t)(m - 2) * DC + ch) : (f32x4){0.f, 0.f, 0.f, 0.f};
            } else { const int si = m - MP, n = si >> 2, s = si & 3;
                u1 = s >= 1 ? *(const GAS f32x4*)(U + (size_t)(m - 1) * DC + ch) : *(const GAS f32x4*)(sc + (size_t)(n * 2 + 1) * DC + ch);
                u2 = s >= 2 ? *(const GAS f32x4*)(U + (size_t)(m - 2) * DC + ch) : *(const GAS f32x4*)(sc + (size_t)(n * 2 + s) * DC + ch);
            }
            const unsigned long long cbw = *(const GAS unsigned long long*)(CB + (size_t)m * DC + ch);
            f32x4 cb; cb.x = __uint_as_float((unsigned)(cbw & 0xffffu) << 16); cb.y = __uint_as_float((unsigned)((cbw >> 16) & 0xffffu) << 16);
            cb.z = __uint_as_float((unsigned)((cbw >> 32) & 0xffffu) << 16); cb.w = __uint_as_float((unsigned)((cbw >> 48) & 0xffffu) << 16);
            const f32x4 y = cb * (w0[j] * u2 + w1[j] * u1 + w2[j] * uc);
            *(GAS unsigned long long*)(A2 + (size_t)m * D + DA + ch) = (unsigned long long)pk2(y.x, y.y) | ((unsigned long long)pk2(y.z, y.w) << 32);
        }
    }
}
constexpr int CMP_NBLKS = NB * NBP + SB * NBS, CMP_UB = 34, CMP_UNITS = CMP_NBLKS / CMP_UB;
static_assert(CMP_UNITS * CMP_UB == CMP_NBLKS, "compress units");
constexpr int CL_PTR = 0, CL_A = 1024, CL_ABYTES = CMP_UB * 512, CL_HID = 36864;
static_assert(CL_A + 2 * CL_ABYTES <= CL_HID, "compress LDS map");
__device__ __forceinline__ void compress_phase(Frame& F, const KArgs& a) {
    typedef short bf16x8v __attribute__((ext_vector_type(8)));
    const int tid = F.tid, lane = F.lane, wid = F.wave;
    const float* pe = (const float*)a.in[17]; const float* w2 = (const float*)a.in[16];
    const bf16* W1T = (const bf16*)(a.ws + WS_W1T); float* KC = (float*)(a.ws + WS_KC);
    const int* pt = (const int*)a.in[6]; const float* pool = (const float*)a.in[2];
    LAS unsigned long long* ptrs = (LAS unsigned long long*)(F.lds + CL_PTR);
    LAS float* hid = (LAS float*)(F.lds + CL_HID);
    const int c_w = wid >> 2, hq = wid & 3;
    for (int unit = F.vcu; unit < CMP_UNITS; unit += F.G) {
        const int blk0 = unit * CMP_UB;
        __syncthreads();
        if (tid < CMP_UB) { const int id = blk0 + tid; const float* src;
            if (id < NB * NBP) { const int n = id >> 5, b = id & 31; src = a.out + O_PCMP + (size_t)(n * T + b * BLK) * KVW; }
            else { const int sid = id - NB * NBP, n = sid >> 8, b = sid & 255; const int page = pt[n * NPAGES + (b >> 1)]; src = pool + ((size_t)page * PAGE + (size_t)(b & 1) * BLK) * KVW; }
            ptrs[tid] = (unsigned long long)(uintptr_t)src; }
        __syncthreads();
        const float* sp[5]; int e4[5]; bool ok[5];
#pragma unroll
        for (int k = 0; k < 5; ++k) { const int f = tid + 512 * k; ok[k] = f < CMP_UB * 64; const int b = ok[k] ? (f >> 6) : 0; e4[k] = f & 63; sp[k] = (const float*)(uintptr_t)ptrs[b] + e4[k] * 4; }
        f32x4 st[5]; bf16x8v bw[2];
#pragma unroll
        for (int k = 0; k < 5; ++k) if (ok[k]) st[k] = *(const GAS f32x4*)(sp[k]);
        const bf16* wrow = W1T + ((size_t)c_w * 64 + hq * 16 + (lane & 15)) * 4096 + 8 * (lane >> 4);
        bw[0] = *(const GAS bf16x8v*)(wrow); bw[1] = *(const GAS bf16x8v*)(wrow + 32);
        f32x4 acc[5];
#pragma unroll
        for (int mt = 0; mt < 5; ++mt) acc[mt] = (f32x4){0.f, 0.f, 0.f, 0.f};
        for (int p = 0; p < BLK; ++p) {
            LAS unsigned char* abuf = F.lds + CL_A + (p & 1) * CL_ABYTES;
#pragma unroll
            for (int k = 0; k < 5; ++k) if (ok[k]) { const int f = tid + 512 * k; const f32x4 pv = *(const GAS f32x4*)(pe + p * 128 + (e4[k] >> 5) * 64 + (e4[k] & 15) * 4); const f32x4 v = st[k] + pv;
                *(LAS unsigned long long*)(abuf + (f >> 6) * 512 + e4[k] * 8) = (unsigned long long)pk2(v.x, v.y) | ((unsigned long long)pk2(v.z, v.w) << 32); }
            const bf16x8v b0 = bw[0], b1 = bw[1];
            if (p + 1 < BLK) {
#pragma unroll
                for (int k = 0; k < 5; ++k) if (ok[k]) st[k] = *(const GAS f32x4*)(sp[k] + (size_t)(p + 1) * KVW);
                bw[0] = *(const GAS bf16x8v*)(wrow + (p + 1) * 64); bw[1] = *(const GAS bf16x8v*)(wrow + (p + 1) * 64 + 32);
            }
            __syncthreads();
#pragma unroll
            for (int mt = 0; mt < 5; ++mt) { int row = mt * 16 + (lane & 15); if (row >= 2 * CMP_UB) row = 2 * CMP_UB - 1;
                const LAS unsigned char* ap = abuf + (row >> 1) * 512 + (c_w * 128 + (row & 1) * 64 + 8 * (lane >> 4)) * 2;
                const bf16x8v a0 = *(const LAS bf16x8v*)(ap), a1 = *(const LAS bf16x8v*)(ap + 64);
                acc[mt] = __builtin_amdgcn_mfma_f32_16x16x32_bf16(a0, b0, acc[mt], 0, 0, 0);
                acc[mt] = __builtin_amdgcn_mfma_f32_16x16x32_bf16(a1, b1, acc[mt], 0, 0, 0); }
        }
#pragma unroll
        for (int mt = 0; mt < 5; ++mt)
#pragma unroll
            for (int i = 0; i < 4; ++i) { const int row = mt * 16 + (lane >> 4) * 4 + i; const float x = acc[mt][i];
                hid[(c_w * 80 + row) * 64 + hq * 16 + (lane & 15)] = x * __builtin_amdgcn_rcpf(1.0f + __builtin_amdgcn_exp2f(-1.4426950408889634f * x)); }
        __syncthreads();
        for (int pr = wid; pr < 2 * 2 * CMP_UB; pr += NWAVES) { const int c = pr / (2 * CMP_UB), row = pr % (2 * CMP_UB);
            const LAS float* hr = hid + (c * 80 + row) * 64; const float* wp = w2 + (size_t)c * 64 * 64 + lane; float s = 0.f;
#pragma unroll 16
            for (int h = 0; h < 64; ++h) s += hr[h] * wp[h * 64];
            KC[(size_t)(blk0 + (row >> 1)) * 256 + c * 128 + (row & 1) * 64 + lane] = s; }
    }
}
__device__ __forceinline__ float bf2f(unsigned short x) { return __uint_as_float((unsigned)x << 16); }
__device__ __forceinline__ int wave_min_i(int v) {
#pragma unroll
    for (int o = 1; o < 64; o <<= 1) { const int t = __shfl_xor(v, o); v = t < v ? t : v; }
    return v;
}
template <bool F32> __device__ __forceinline__ void dot4h(const void* krow, const LAS float* qf, float (&s)[4]) {
    s[0] = s[1] = s[2] = s[3] = 0.f;
    if (F32) {
#pragma unroll
        for (int d4 = 0; d4 < 16; ++d4) { const f32x4 k = ((const GAS f32x4*)krow)[d4];
#pragma unroll
            for (int h = 0; h < 4; ++h) { const f32x4 q = ((const LAS f32x4*)qf)[h * 16 + d4]; s[h] += (k.x * q.x + k.y * q.y) + (k.z * q.z + k.w * q.w); } }
    } else {
#pragma unroll
        for (int d8 = 0; d8 < 8; ++d8) { const v4u kk = ((const GAS v4u*)krow)[d8];
            const f32x4 k0 = {__uint_as_float(kk.x << 16), __uint_as_float(kk.x & 0xffff0000u), __uint_as_float(kk.y << 16), __uint_as_float(kk.y & 0xffff0000u)};
            const f32x4 k1 = {__uint_as_float(kk.z << 16), __uint_as_float(kk.z & 0xffff0000u), __uint_as_float(kk.w << 16), __uint_as_float(kk.w & 0xffff0000u)};
#pragma unroll
            for (int h = 0; h < 4; ++h) { const f32x4 q0 = ((const LAS f32x4*)qf)[h * 16 + 2 * d8], q1 = ((const LAS f32x4*)qf)[h * 16 + 2 * d8 + 1];
                s[h] += ((k0.x * q0.x + k0.y * q0.y) + (k0.z * q0.z + k0.w * q0.w)) + ((k1.x * q1.x + k1.y * q1.y) + (k1.z * q1.z + k1.w * q1.w)); } }
    }
}
__device__ __forceinline__ void osm_update(const float (&s)[4], bool valid, float (&m)[4], float (&l)[4], float (&o)[4], LAS float* pb, int lane) {
#pragma unroll
    for (int h = 0; h < 4; ++h) {
        const float mb = wave_max(valid ? s[h] : -INFINITY);
        const float mn = fmaxf(m[h], mb);
        const float al = (m[h] == -INFINITY) ? 0.f : __builtin_amdgcn_exp2f(m[h] - mn);
        const float p = valid ? __builtin_amdgcn_exp2f(s[h] - mn) : 0.f;
        l[h] = l[h] * al + wave_sum(p); o[h] *= al; m[h] = mn; pb[h * 64 + lane] = p;
    }
}
template <bool SAMPLE> __device__ __forceinline__ void attn_task(Frame& F, const KArgs& a, int n, int g, int tq) {
    const int lane = F.lane;
    LAS float* wl = (LAS float*)(F.lds + F.wave * 16384);
    LAS float* qf = wl; LAS float* pb = wl + 256; LAS int* sl = (LAS int*)(wl + 256 + 1024);
    const int row = SAMPLE ? MP + n * SS + tq : n * T + tq;
    const int qpos = SAMPLE ? PAST + tq : tq;
    const unsigned char* ws = a.ws;
    const bf16* Q = (const bf16*)(ws + WS_Q); const bf16* KS = (const bf16*)(ws + WS_KS); const bf16* KW = (const bf16*)(ws + WS_KW);
    LDS_WAIT(); asm volatile("" ::: "memory");
#pragma unroll
    for (int h = 0; h < 4; ++h) qf[h * 64 + lane] = bf2f(Q[(size_t)row * DA + (g * 4 + h) * 64 + lane]);
    LDS_WAIT(); asm volatile("" ::: "memory");
    constexpr int NBLK = SAMPLE ? NBS : NBP, NC = SAMPLE ? 4 : 1;
    const float* KC = (const float*)(ws + WS_KC) + (size_t)(SAMPLE ? (NB * NBP + n * NBS) : n * NBP) * 256;
    float imp[NC]; float ocmp[4] = {0.f, 0.f, 0.f, 0.f};
    {
#pragma unroll 1
        for (int jj = 0; jj < NC; ++jj) { const int j = lane + 64 * jj; const bool vis = (j < NBLK) && ((j + 1) * BLK - 1 <= qpos);
            if (j < NBLK) { float s4[4]; dot4h<true>(KC + (size_t)j * 256 + g * 64, qf, s4);
#pragma unroll
                for (int h = 0; h < 4; ++h) pb[h * 256 + j] = vis ? s4[h] : -INFINITY; } }
        LDS_WAIT(); asm volatile("" ::: "memory");
#pragma unroll
        for (int jj = 0; jj < NC; ++jj) imp[jj] = 0.f;
#pragma unroll
        for (int h = 0; h < 4; ++h) {
            float sv[NC]; float mx = -INFINITY;
#pragma unroll
            for (int jj = 0; jj < NC; ++jj) { sv[jj] = (lane + 64 * jj < NBLK) ? pb[h * 256 + lane + 64 * jj] : -INFINITY; mx = fmaxf(mx, sv[jj]); }
            mx = wave_max(mx);
            float e[NC], sum = 0.f;
#pragma unroll
            for (int jj = 0; jj < NC; ++jj) { e[jj] = (sv[jj] > -INFINITY) ? __builtin_amdgcn_exp2f(sv[jj] - mx) : 0.f; sum += e[jj]; }
            sum = wave_sum(sum); const float inv = sum > 0.f ? 1.0f / sum : 0.f;
#pragma unroll
            for (int jj = 0; jj < NC; ++jj) { const float p = e[jj] * inv; imp[jj] += p; if (lane + 64 * jj < NBLK) pb[h * 256 + lane + 64 * jj] = p; }
        }
        LDS_WAIT(); asm volatile("" ::: "memory");
        int nvis = (qpos + 1) / BLK; if (nvis > NBLK) nvis = NBLK;
        for (int j = 0; j < nvis; ++j) { const float v = KC[(size_t)j * 256 + 128 + g * 64 + lane];
#pragma unroll
            for (int h = 0; h < 4; ++h) ocmp[h] += pb[h * 256 + j] * v; }
        LDS_WAIT(); asm volatile("" ::: "memory");
    }
    const int cur = qpos >> 6;
    {
        float cand[NC];
#pragma unroll
        for (int jj = 0; jj < NC; ++jj) { const int j = lane + 64 * jj;
            cand[jj] = (j >= NBLK) ? -INFINITY : (j > cur) ? -1e30f : (j == 0 || j == cur || j == cur - 1) ? 1e4f : imp[jj]; }
        constexpr int NIT = SAMPLE ? NSEL - 1 : NSEL;
        for (int it = 0; it < NIT; ++it) {
            float lm = cand[0];
#pragma unroll
            for (int jj = 1; jj < NC; ++jj) lm = fmaxf(lm, cand[jj]);
            const float mx = wave_max(lm);
            int lj = 0x7fffffff;
#pragma unroll
            for (int jj = NC - 1; jj >= 0; --jj) if (cand[jj] == mx) lj = lane + 64 * jj;
            const int sj = wave_min_i(lj);
            if (lane == 0) sl[it] = sj;
#pragma unroll
            for (int jj = 0; jj < NC; ++jj) if (lane + 64 * jj == sj) cand[jj] = -INFINITY;
        }
        if (SAMPLE) { if (lane == 0) sl[NSEL - 1] = NBS; }
        LDS_WAIT(); asm volatile("" ::: "memory");
    }
    float osel[4] = {0.f, 0.f, 0.f, 0.f};
    {
        float m[4] = {-INFINITY, -INFINITY, -INFINITY, -INFINITY}, l[4] = {0.f, 0.f, 0.f, 0.f};
        for (int i = 0; i < NSEL; ++i) {
            const int j = __builtin_amdgcn_readfirstlane(sl[i]);
            if (j > cur) continue;
            const int kpos = j * BLK + lane; const bool valid = kpos <= qpos;
            float s[4];
            if (!SAMPLE) {
                const bf16* kb = KS + (size_t)(n * T + j * BLK) * KVW + g * 64;
                dot4h<false>(kb + (size_t)lane * KVW, qf, s);
                osm_update(s, valid, m, l, osel, pb, lane);
                LDS_WAIT(); asm volatile("" ::: "memory");
                for (int k = 0; k < BLK; ++k) { const float v = bf2f(kb[(size_t)k * KVW + 128 + lane]);
#pragma unroll
                    for (int h = 0; h < 4; ++h) osel[h] += pb[h * 64 + k] * v; }
            } else {
                const float* kb; int nk = BLK;
                if (j < NBS) { const int page = ((const int*)a.in[6])[n * NPAGES + (j >> 1)]; kb = (const float*)a.in[3] + ((size_t)page * PAGE + (size_t)(j & 1) * BLK) * KVW + g * 64; }
                else { kb = a.out + O_SSEL + (size_t)(n * SS) * KVW + g * 64; nk = SS; }
                const int kl = lane < nk ? lane : nk - 1;
                dot4h<true>(kb + (size_t)kl * KVW, qf, s);
                osm_update(s, valid && lane < nk, m, l, osel, pb, lane);
                LDS_WAIT(); asm volatile("" ::: "memory");
                for (int k = 0; k < nk; ++k) { const float v = kb[(size_t)k * KVW + 128 + lane];
#pragma unroll
                    for (int h = 0; h < 4; ++h) osel[h] += pb[h * 64 + k] * v; }
            }
            LDS_WAIT(); asm volatile("" ::: "memory");
        }
#pragma unroll
        for (int h = 0; h < 4; ++h) osel[h] = l[h] > 0.f ? osel[h] / l[h] : 0.f;
    }
    float owin[4] = {0.f, 0.f, 0.f, 0.f};
    {
        float m[4] = {-INFINITY, -INFINITY, -INFINITY, -INFINITY}, l[4] = {0.f, 0.f, 0.f, 0.f};
        for (int c = 0; c < WIN / 64; ++c) {
            float s[4];
            if (!SAMPLE) {
                const int k0 = qpos - (WIN - 1) + 64 * c; if (k0 + 63 < 0) continue;
                const int kpos = k0 + lane; const bool valid = kpos >= 0; const int kc = valid ? kpos : 0;
                dot4h<false>(KW + (size_t)(n * T + kc) * KVW + g * 64, qf, s);
                osm_update(s, valid, m, l, owin, pb, lane);
                LDS_WAIT(); asm volatile("" ::: "memory");
                for (int k = 0; k < 64; ++k) { const int kp = k0 + k; if (kp < 0) continue; const float v = bf2f(KW[(size_t)(n * T + kp) * KVW + 128 + g * 64 + lane]);
#pragma unroll
                    for (int h = 0; h < 4; ++h) owin[h] += pb[h * 64 + k] * v; }
            } else {
                const int i0 = tq + 1 + 64 * c;
                const float* st = (const float*)a.in[4] + (size_t)n * WIN * KVW; const float* nw = a.out + O_SWIN + (size_t)(n * WIN + (WIN - SS)) * KVW;
                const int i = i0 + lane; const float* kr = (i < WIN ? st + (size_t)i * KVW : nw + (size_t)(i - WIN) * KVW) + g * 64;
                dot4h<true>(kr, qf, s);
                osm_update(s, true, m, l, owin, pb, lane);
                LDS_WAIT(); asm volatile("" ::: "memory");
                for (int k = 0; k < 64; ++k) { const int ik = i0 + k; const float v = (ik < WIN ? st + (size_t)ik * KVW : nw + (size_t)(ik - WIN) * KVW)[128 + g * 64 + lane];
#pragma unroll
                    for (int h = 0; h < 4; ++h) owin[h] += pb[h * 64 + k] * v; }
            }
            LDS_WAIT(); asm volatile("" ::: "memory");
        }
#pragma unroll
        for (int h = 0; h < 4; ++h) owin[h] = l[h] > 0.f ? owin[h] / l[h] : 0.f;
    }
    const float* G = (const float*)(ws + WS_G) + (size_t)row * 32; bf16* A2 = (bf16*)(ws + WS_A2);
#pragma unroll
    for (int h = 0; h < 4; ++h) { const int hh = g * 4 + h; const float o = G[hh] * ocmp[h] + G[8 + hh] * osel[h] + G[16 + hh] * owin[h];
        A2[(size_t)row * D + hh * 64 + lane] = (bf16)f2bf(o); }
}
__device__ __forceinline__ void attn_phase(Frame& F, const KArgs& a) {
    { const int gt = F.vcu * (NWAVES * 64) + F.tid, NGT = F.G * NWAVES * 64; bf16* A2 = (bf16*)(a.ws + WS_A2);
      for (int i = gt; i < (M - MR) * (D / 8); i += NGT) *(GAS v4u*)(A2 + (size_t)MR * D + (size_t)i * 8) = (v4u){0u, 0u, 0u, 0u}; }
#ifndef NO_SAMPLE
    for (int task = F.vcu + F.G * F.wave; task < SB * NKV * SS; task += F.G * NWAVES) { const int n = task >> 3, g = (task >> 2) & 1, s = task & 3; attn_task<true>(F, a, n, g, s); }
#endif
#ifndef NO_PROMPT
    const int per = (NB * NKV * T + F.G - 1) / F.G;
    for (int i = F.wave; i < per; i += NWAVES) { const int task = F.vcu * per + i; if (task >= NB * NKV * T) break;
        const int n = task >> 12, g = (task >> 11) & 1, t = task & (T - 1); attn_task<false>(F, a, n, g, t); }
#endif
}
namespace sattn {
constexpr int S_Q = 0, S_SC = 1024, S_SL = 5120, S_PART = 8192, S_ML = 16384, S_PB = 20480, S_OC = 28672, S_OS = 29696;
__device__ __forceinline__ void pv_rows(const float* vb, int nk, const LAS float* pb, float (&o)[4]) {
    if (nk == 64) {
#pragma unroll 16
        for (int k = 0; k < 64; ++k) { const float v = vb[(size_t)k * KVW];
#pragma unroll
            for (int h = 0; h < 4; ++h) o[h] += pb[h * 64 + k] * v; }
    } else {
        for (int k = 0; k < nk; ++k) { const float v = vb[(size_t)k * KVW];
#pragma unroll
            for (int h = 0; h < 4; ++h) o[h] += pb[h * 64 + k] * v; }
    }
}
__device__ __forceinline__ void put_partial(LAS unsigned char* lds, int wid, int lane, const float (&m)[4], const float (&l)[4], const float (&o)[4]) {
    LAS float* part = (LAS float*)(lds + S_PART) + wid * 256; LAS float* ml = (LAS float*)(lds + S_ML) + wid * 8;
#pragma unroll
    for (int h = 0; h < 4; ++h) { part[h * 64 + lane] = o[h]; if (lane == 0) { ml[h * 2] = m[h]; ml[h * 2 + 1] = l[h]; } }
}
__device__ __forceinline__ float combine(const LAS unsigned char* lds, int h, int lane) {
    const LAS float* part = (const LAS float*)(lds + S_PART); const LAS float* ml = (const LAS float*)(lds + S_ML);
    float M = -INFINITY;
#pragma unroll
    for (int w = 0; w < 8; ++w) M = fmaxf(M, ml[w * 8 + h * 2]);
    float o = 0.f, l = 0.f;
#pragma unroll
    for (int w = 0; w < 8; ++w) { const float mw = ml[w * 8 + h * 2]; const float f = (mw == -INFINITY) ? 0.f : __builtin_amdgcn_exp2f(mw - M); o += f * part[w * 256 + h * 64 + lane]; l += f * ml[w * 8 + h * 2 + 1]; }
    return l > 0.f ? o / l : 0.f;
}
__device__ __forceinline__ void task(Frame& F, const KArgs& a, int n, int g, int s) {
    LAS unsigned char* lds = F.lds; const int tid = F.tid, lane = F.lane, wid = F.wave;
    const int row = MP + n * SS + s, qpos = PAST + s;
    const unsigned char* ws = a.ws;
    LAS float* qf = (LAS float*)(lds + S_Q); LAS float* scp = (LAS float*)(lds + S_SC); LAS int* sl = (LAS int*)(lds + S_SL); LAS float* pb = (LAS float*)(lds + S_PB) + wid * 256;
    const float* KC = (const float*)(ws + WS_KC) + (size_t)(NB * NBP + n * NBS) * 256;
    __syncthreads();
    if (tid < 256) qf[tid] = bf2f(((const bf16*)(ws + WS_Q))[(size_t)row * DA + (g * 4 + (tid >> 6)) * 64 + (tid & 63)]);
    __syncthreads();
    { const int j = tid >> 1, dh = tid & 1; const GAS f32x4* kr = (const GAS f32x4*)(KC + (size_t)j * 256 + g * 64 + 32 * dh);
      float sc[4] = {0.f, 0.f, 0.f, 0.f};
#pragma unroll
      for (int d4 = 0; d4 < 8; ++d4) { const f32x4 k = kr[d4];
#pragma unroll
          for (int h = 0; h < 4; ++h) { const f32x4 q = ((const LAS f32x4*)qf)[h * 16 + 8 * dh + d4]; sc[h] += (k.x * q.x + k.y * q.y) + (k.z * q.z + k.w * q.w); } }
#pragma unroll
      for (int h = 0; h < 4; ++h) { sc[h] += __shfl_xor(sc[h], 1); if (dh == 0) scp[h * 256 + j] = sc[h]; } }
    __syncthreads();
    if (wid < 4) { float v[4], mx = -INFINITY;
#pragma unroll
        for (int jj = 0; jj < 4; ++jj) { v[jj] = scp[wid * 256 + lane + 64 * jj]; mx = fmaxf(mx, v[jj]); }
        mx = wave_max(mx); float sum = 0.f;
#pragma unroll
        for (int jj = 0; jj < 4; ++jj) { v[jj] = __builtin_amdgcn_exp2f(v[jj] - mx); sum += v[jj]; }
        sum = wave_sum(sum); const float inv = 1.0f / sum;
#pragma unroll
        for (int jj = 0; jj < 4; ++jj) scp[wid * 256 + lane + 64 * jj] = v[jj] * inv; }
    __syncthreads();
    { float o[4] = {0.f, 0.f, 0.f, 0.f}; const float* vb = KC + (size_t)(32 * wid) * 256 + 128 + g * 64 + lane;
#pragma unroll
      for (int k = 0; k < 32; ++k) { const float v = vb[(size_t)k * 256];
#pragma unroll
          for (int h = 0; h < 4; ++h) o[h] += scp[h * 256 + 32 * wid + k] * v; }
      LAS float* part = (LAS float*)(lds + S_PART) + wid * 256;
#pragma unroll
      for (int h = 0; h < 4; ++h) part[h * 64 + lane] = o[h]; }
    __syncthreads();
    if (wid == 0) {
        float cand[4];
#pragma unroll
        for (int jj = 0; jj < 4; ++jj) { const int j = lane + 64 * jj; const float imp = (scp[j] + scp[256 + j]) + (scp[512 + j] + scp[768 + j]);
            cand[jj] = (j == 0 || j == NBS - 1) ? 1e4f : imp; }
        for (int it = 0; it < NSEL - 1; ++it) {
            const float mx = wave_max(fmaxf(fmaxf(cand[0], cand[1]), fmaxf(cand[2], cand[3])));
            int lj = 0x7fffffff;
#pragma unroll
            for (int jj = 3; jj >= 0; --jj) if (cand[jj] == mx) lj = lane + 64 * jj;
            const int sj = wave_min_i(lj);
            if (lane == 0) sl[it] = sj;
#pragma unroll
            for (int jj = 0; jj < 4; ++jj) if (lane + 64 * jj == sj) cand[jj] = -INFINITY;
        }
        if (lane == 0) sl[NSEL - 1] = NBS;
    } else if (wid <= 4) { const int h = wid - 1; const LAS float* part = (const LAS float*)(lds + S_PART); float o = 0.f;
#pragma unroll
        for (int w = 0; w < 8; ++w) o += part[w * 256 + h * 64 + lane];
        ((LAS float*)(lds + S_OC))[h * 64 + lane] = o; }
    __syncthreads();
    {
        float m[4] = {-INFINITY, -INFINITY, -INFINITY, -INFINITY}, l[4] = {0.f, 0.f, 0.f, 0.f}, o[4] = {0.f, 0.f, 0.f, 0.f};
        for (int i = 2 * wid; i < 2 * wid + 2; ++i) {
            const int j = __builtin_amdgcn_readfirstlane(sl[i]);
            const float* kb; int nk = BLK;
            if (j < NBS) { const int page = ((const int*)a.in[6])[n * NPAGES + (j >> 1)]; kb = (const float*)a.in[3] + ((size_t)page * PAGE + (size_t)(j & 1) * BLK) * KVW + g * 64; }
            else { kb = a.out + O_SSEL + (size_t)(n * SS) * KVW + g * 64; nk = SS; }
            const int kl = lane < nk ? lane : nk - 1; const bool valid = (j * BLK + lane <= qpos) && lane < nk;
            float sc[4]; dot4h<true>(kb + (size_t)kl * KVW, qf, sc);
            osm_update(sc, valid, m, l, o, pb, lane);
            LDS_WAIT(); asm volatile("" ::: "memory");
            pv_rows(kb + 128 + lane, nk, pb, o);
            LDS_WAIT(); asm volatile("" ::: "memory");
        }
        put_partial(lds, wid, lane, m, l, o);
    }
    __syncthreads();
    if (wid < 4) ((LAS float*)(lds + S_OS))[wid * 64 + lane] = combine(lds, wid, lane);
    __syncthreads();
    {
        float m[4] = {-INFINITY, -INFINITY, -INFINITY, -INFINITY}, l[4] = {0.f, 0.f, 0.f, 0.f}, o[4] = {0.f, 0.f, 0.f, 0.f};
        const int i0 = s + 1 + 64 * wid;
        const float* st = (const float*)a.in[4] + (size_t)n * WIN * KVW; const float* nw = a.out + O_SWIN + (size_t)(n * WIN + (WIN - SS)) * KVW;
        const int i = i0 + lane; const float* kr = (i < WIN ? st + (size_t)i * KVW : nw + (size_t)(i - WIN) * KVW) + g * 64;
        float sc[4]; dot4h<true>(kr, qf, sc);
        osm_update(sc, true, m, l, o, pb, lane);
        LDS_WAIT(); asm volatile("" ::: "memory");
        if (i0 + 63 < WIN) pv_rows(st + (size_t)i0 * KVW + 128 + g * 64 + lane, 64, pb, o);
        else { for (int k = 0; k < 64; ++k) { const int ik = i0 + k; const float v = (ik < WIN ? st + (size_t)ik * KVW : nw + (size_t)(ik - WIN) * KVW)[128 + g * 64 + lane];
#pragma unroll
                for (int h = 0; h < 4; ++h) o[h] += pb[h * 64 + k] * v; } }
        put_partial(lds, wid, lane, m, l, o);
    }
    __syncthreads();
    if (wid < 4) { const int hh = g * 4 + wid; const float ow = combine(lds, wid, lane); const float* G = (const float*)(ws + WS_G) + (size_t)row * 32;
        const float o = G[hh] * ((const LAS float*)(lds + S_OC))[wid * 64 + lane] + G[8 + hh] * ((const LAS float*)(lds + S_OS))[wid * 64 + lane] + G[16 + hh] * ow;
        ((bf16*)(ws + WS_A2))[(size_t)row * D + hh * 64 + lane] = (bf16)f2bf(o); }
}
}
namespace pattn {
typedef short bf16x8 __attribute__((ext_vector_type(8)));
typedef short s16x4 __attribute__((ext_vector_type(4)));
typedef float f32x16 __attribute__((ext_vector_type(16)));
constexpr int L_KV = 32768, SLOT = 16384;
constexpr int L_KC = 65536;
constexpr int L_IMP = 0;
constexpr int L_SELM = 73728, L_UNI = L_SELM + 256;
__device__ __forceinline__ int crow(int r, int hi) { return (r & 3) + 8 * (r >> 2) + 4 * hi; }
__device__ __forceinline__ unsigned cvtpk(float lo, float hi) { typedef float f2 __attribute__((ext_vector_type(2))); typedef __bf16 b2 __attribute__((ext_vector_type(2))); f2 v = {lo, hi}; b2 b = __builtin_convertvector(v, b2); return __builtin_bit_cast(unsigned, b); }
__device__ __forceinline__ float swapmax(float v) { auto rr = __builtin_amdgcn_permlane32_swap(__float_as_uint(v), __float_as_uint(v), false, false); return fmaxf(__uint_as_float(rr[0]), __uint_as_float(rr[1])); }
__device__ __forceinline__ float swapsum(float v) { auto rr = __builtin_amdgcn_permlane32_swap(__float_as_uint(v), __float_as_uint(v), false, false); return __uint_as_float(rr[0]) + __uint_as_float(rr[1]); }
typedef short v4i16_t __attribute__((ext_vector_type(4)));
__device__ __forceinline__ s16x4 vtr(const LAS unsigned char* p) { return __builtin_bit_cast(s16x4, __builtin_amdgcn_ds_read_tr16_b64_v4i16((LAS v4i16_t*)p)); }
__device__ __forceinline__ bf16x8 vfrag(const LAS unsigned char* p) { const s16x4 lo = vtr(p), hi = vtr(p + 512); return (bf16x8){lo[0], lo[1], lo[2], lo[3], hi[0], hi[1], hi[2], hi[3]}; }
#define PK8(P, B) __builtin_bit_cast(bf16x8, (v4u){cvtpk(P[B], P[B + 1]), cvtpk(P[B + 2], P[B + 3]), cvtpk(P[B + 4], P[B + 5]), cvtpk(P[B + 6], P[B + 7])})

template <int MODE> __device__ __forceinline__ void block_step(const LAS unsigned char* sb, const bf16x8 (&qr)[4], int j, int c, int tl, unsigned mymask, int r32, int hh, int voff,
                                                               float& m, float& l, f32x16 (&o)[2]) {
    f32x16 p0 = {}, p1 = {};
#pragma unroll
    for (int d0 = 0; d0 < 4; ++d0) { const LAS unsigned char* kb = sb + (2 * d0 + hh) * 1024 + r32 * 16;
        const bf16x8 b0 = *(const LAS bf16x8*)kb, b1 = *(const LAS bf16x8*)(kb + 512);
        p0 = __builtin_amdgcn_mfma_f32_32x32x16_bf16(b0, qr[d0], p0, 0, 0, 0); p1 = __builtin_amdgcn_mfma_f32_32x32x16_bf16(b1, qr[d0], p1, 0, 0, 0); }
    __builtin_amdgcn_sched_barrier(0);
    int tlo = tl; asm volatile("" : "+v"(tlo));
    if (MODE == 0) { if (!((mymask >> j) & 1u)) {
#pragma unroll
            for (int r = 0; r < 16; ++r) { p0[r] = -INFINITY; p1[r] = -INFINITY; } } }
    if (j == c) {
#pragma unroll
        for (int r = 0; r < 16; ++r) { const int kl = crow(r, hh); if (kl > tlo) p0[r] = -INFINITY; if (kl + 32 > tlo) p1[r] = -INFINITY; } }
    if (MODE == 1) { if (j == c - 8) {
#pragma unroll
            for (int r = 0; r < 16; ++r) { const int kl = crow(r, hh); if (kl <= tlo) p0[r] = -INFINITY; if (kl + 32 <= tlo) p1[r] = -INFINITY; } } }
    float mx = fmaxf(p0[0], p1[0]);
#pragma unroll
    for (int r = 1; r < 16; ++r) mx = fmaxf(mx, fmaxf(p0[r], p1[r]));
    mx = swapmax(mx);
    const float mn = fmaxf(m, mx), al = __builtin_amdgcn_exp2f(m - mn); m = mn;
    float s = 0.f;
#pragma unroll
    for (int r = 0; r < 16; ++r) { p0[r] = __builtin_amdgcn_exp2f(p0[r] - mn); p1[r] = __builtin_amdgcn_exp2f(p1[r] - mn); s += p0[r] + p1[r]; }
    l = l * al + s;
#pragma unroll
    for (int r = 0; r < 16; ++r) { o[0][r] *= al; o[1][r] *= al; }
    const bf16x8 pw0 = PK8(p0, 0), pw1 = PK8(p0, 8), pw2 = PK8(p1, 0), pw3 = PK8(p1, 8);
    const LAS unsigned char* vb = sb + 8192 + voff;
    __builtin_amdgcn_sched_barrier(0);
#pragma unroll
    for (int d0 = 0; d0 < 2; ++d0) {
        if (d0 == 1) __builtin_amdgcn_sched_barrier(0);
        o[d0] = __builtin_amdgcn_mfma_f32_32x32x16_bf16(vfrag(vb + (d0 * 4 + 0) * 1024), pw0, o[d0], 0, 0, 0);
        o[d0] = __builtin_amdgcn_mfma_f32_32x32x16_bf16(vfrag(vb + (d0 * 4 + 1) * 1024), pw1, o[d0], 0, 0, 0);
        __builtin_amdgcn_sched_barrier(0);
        o[d0] = __builtin_amdgcn_mfma_f32_32x32x16_bf16(vfrag(vb + (d0 * 4 + 2) * 1024), pw2, o[d0], 0, 0, 0);
        o[d0] = __builtin_amdgcn_mfma_f32_32x32x16_bf16(vfrag(vb + (d0 * 4 + 3) * 1024), pw3, o[d0], 0, 0, 0);
    }
}
template <int MODE> __device__ __forceinline__ void run_branch(LAS unsigned char* lds, const bf16* src, int n, int g, unsigned blocks, const bf16x8 (&qr)[4], int c, int tl, unsigned mymask,
                                                               int tid, int r32, int hh, int voff, float gate, f32x16 (&ofin)[2]) {
    const int lane = tid & 63, wid = tid >> 6;
    float m = -1e30f, l = 0.f; f32x16 o[2] = {};
    const bf16* kg = src + (size_t)(n * T + lane) * KVW + g * 64 + wid * 8;
    const bf16* vg = src + (size_t)(n * T + 16 * (wid & 3) + (lane >> 2)) * KVW + 128 + g * 64 + (wid >> 2) * 32 + (lane & 3) * 8;
    const int kdst = wid * 1024 + lane * 16, vdst = 8192 + wid * 1024 + lane * 16;
    unsigned rem = blocks; int j = __builtin_ctz(rem); rem &= rem - 1;
    v4u kreg = *(const GAS v4u*)(kg + (size_t)j * BLK * KVW), vreg = *(const GAS v4u*)(vg + (size_t)j * BLK * KVW);
    int slot = 0;
    for (;;) {
        LAS unsigned char* sb = lds + L_KV + slot * SLOT;
        *(LAS v4u*)(sb + kdst) = kreg; *(LAS v4u*)(sb + vdst) = vreg;
        const int jn = rem ? __builtin_ctz(rem) : -1;
        if (jn >= 0) { kreg = *(const GAS v4u*)(kg + (size_t)jn * BLK * KVW); vreg = *(const GAS v4u*)(vg + (size_t)jn * BLK * KVW); }
        __syncthreads();
        block_step<MODE>(sb, qr, j, c, tl, mymask, r32, hh, voff, m, l, o);
        if (jn < 0) break;
        j = jn; rem &= rem - 1; slot ^= 1;
    }
    l = swapsum(l);
    const float sc = l > 0.f ? gate / l : 0.f;
#pragma unroll
    for (int r = 0; r < 16; ++r) { ofin[0][r] += sc * o[0][r]; ofin[1][r] += sc * o[1][r]; }
}
__device__ __forceinline__ void unit(Frame& F, const KArgs& a, int n, int g, int c) {
    LAS unsigned char* lds = F.lds;
    int tid = F.tid; asm volatile("" : "+v"(tid));
    const int lane = tid & 63, wid = F.wave, r32 = lane & 31, hh = lane >> 5, hl = wid >> 1, qsub = wid & 1, tl = 32 * qsub + r32;
    const int h = g * 4 + hl, row = n * T + 64 * c + tl;
    const unsigned char* ws = a.ws;
    const bf16* Q = (const bf16*)(ws + WS_Q); const float* KC = (const float*)(ws + WS_KC) + (size_t)(n * NBP) * 256; const float* G = (const float*)(ws + WS_G) + (size_t)row * 32;
    const int voff = ((lane >> 4) & 1) * 32 + (lane & 3) * 8 + (4 * hh + ((lane & 15) >> 2)) * 64;
    __syncthreads();
    { const int j = tid >> 4, d = (tid & 15) * 4;
      const f32x4 kc = *(const GAS f32x4*)(KC + (size_t)j * 256 + g * 64 + d), vc = *(const GAS f32x4*)(KC + (size_t)j * 256 + 128 + g * 64 + d);
      *(LAS unsigned long long*)(lds + L_KC + (d >> 3) * 512 + j * 16 + (d & 7) * 2) = (unsigned long long)pk2(kc.x, kc.y) | ((unsigned long long)pk2(kc.z, kc.w) << 32);
      *(LAS unsigned long long*)(lds + L_KC + 4096 + ((d >> 5) * 2 + (j >> 4)) * 1024 + (j & 15) * 64 + (d & 31) * 2) = (unsigned long long)pk2(vc.x, vc.y) | ((unsigned long long)pk2(vc.z, vc.w) << 32);
      if (tid < 65) ((LAS unsigned*)(lds + L_SELM))[tid] = 0u; }
    bf16x8 qr[4];
#pragma unroll
    for (int d0 = 0; d0 < 4; ++d0) qr[d0] = *(const GAS bf16x8*)(Q + (size_t)row * DA + h * 64 + d0 * 16 + hh * 8);
    const float g_cmp = G[h], g_sel = G[8 + h], g_win = G[16 + h];
    __syncthreads();
    f32x16 ofin[2] = {};
    {
        f32x16 p = {};
#pragma unroll
        for (int d0 = 0; d0 < 4; ++d0) { const bf16x8 kf = *(const LAS bf16x8*)(lds + L_KC + (2 * d0 + hh) * 512 + r32 * 16); p = __builtin_amdgcn_mfma_f32_32x32x16_bf16(kf, qr[d0], p, 0, 0, 0); }
        const int jlim = (tl == 63) ? c : c - 1;
        float mx = -INFINITY;
#pragma unroll
        for (int r = 0; r < 16; ++r) { if (crow(r, hh) > jlim) p[r] = -INFINITY; mx = fmaxf(mx, p[r]); }
        mx = swapmax(mx);
        const float mref = mx > -INFINITY ? mx : 0.f; float s = 0.f;
#pragma unroll
        for (int r = 0; r < 16; ++r) { p[r] = __builtin_amdgcn_exp2f(p[r] - mref); s += p[r]; }
        s = swapsum(s); const float inv = s > 0.f ? 1.0f / s : 0.f;
        LAS float* imp = (LAS float*)(lds + L_IMP);
#pragma unroll
        for (int r = 0; r < 16; ++r) { p[r] *= inv; imp[(hl * 32 + crow(r, hh)) * 64 + tl] = p[r]; }
        const bf16x8 pc0 = PK8(p, 0), pc1 = PK8(p, 8);
        f32x16 oc[2] = {};
        const LAS unsigned char* vb = lds + L_KC + 4096 + voff;
#pragma unroll
        for (int d0 = 0; d0 < 2; ++d0) { oc[d0] = __builtin_amdgcn_mfma_f32_32x32x16_bf16(vfrag(vb + (d0 * 2 + 0) * 1024), pc0, oc[d0], 0, 0, 0);
                                         oc[d0] = __builtin_amdgcn_mfma_f32_32x32x16_bf16(vfrag(vb + (d0 * 2 + 1) * 1024), pc1, oc[d0], 0, 0, 0); }
#pragma unroll
        for (int r = 0; r < 16; ++r) { ofin[0][r] = g_cmp * oc[0][r]; ofin[1][r] = g_cmp * oc[1][r]; }
    }
    __syncthreads();
    {
        const LAS float* imp = (const LAS float*)(lds + L_IMP);
        const unsigned negm = (c == 31) ? 0u : ~((2u << c) - 1u), forcem = 1u | (1u << c) | (c >= 1 ? (1u << (c - 1)) : 0u);
        float sc[32];
#pragma unroll
        for (int j = 0; j < 32; ++j) { const float v = (imp[(0 * 32 + j) * 64 + lane] + imp[(1 * 32 + j) * 64 + lane]) + (imp[(2 * 32 + j) * 64 + lane] + imp[(3 * 32 + j) * 64 + lane]);
            sc[j] = ((negm >> j) & 1u) ? -1e30f : ((forcem >> j) & 1u) ? 1e4f : v; }
        unsigned bits = 0u;
#pragma unroll
        for (int k = 0; k < 4; ++k) { const int jm = 4 * wid + k;
            const float v = (imp[(0 * 32 + jm) * 64 + lane] + imp[(1 * 32 + jm) * 64 + lane]) + (imp[(2 * 32 + jm) * 64 + lane] + imp[(3 * 32 + jm) * 64 + lane]);
            const float my = ((negm >> jm) & 1u) ? -1e30f : ((forcem >> jm) & 1u) ? 1e4f : v;
            int rank = 0;
#pragma unroll
            for (int j = 0; j < 32; ++j) rank += (sc[j] > my || (sc[j] == my && j < jm)) ? 1 : 0;
            if (rank < NSEL) bits |= 1u << jm; }
        if (bits) { atomicOr((unsigned*)(lds + L_SELM) + lane, bits); atomicOr((unsigned*)(lds + L_UNI), bits); }
    }
    __syncthreads();
    const unsigned mymask = ((const LAS unsigned*)(lds + L_SELM))[tl];
    const unsigned cmask = (c == 31) ? 0xffffffffu : ((2u << c) - 1u);
    const unsigned uni = (unsigned)__builtin_amdgcn_readfirstlane(*(const LAS unsigned*)(lds + L_UNI)) & cmask;
    run_branch<0>(lds, (const bf16*)(ws + WS_KS), n, g, uni, qr, c, tl, mymask, tid, r32, hh, voff, g_sel, ofin);
    __syncthreads();
    const unsigned wmask = cmask & ~((c >= 8) ? ((1u << (c - 8)) - 1u) : 0u);
    run_branch<1>(lds, (const bf16*)(ws + WS_KW), n, g, wmask, qr, c, tl, mymask, tid, r32, hh, voff, g_win, ofin);
    bf16* A2 = (bf16*)(ws + WS_A2) + (size_t)row * D + h * 64;
#pragma unroll
    for (int d0 = 0; d0 < 2; ++d0)
#pragma unroll
        for (int r4 = 0; r4 < 4; ++r4) { const int d = 32 * d0 + 8 * r4 + 4 * hh;
            *(GAS unsigned long long*)(A2 + d) = (unsigned long long)cvtpk(ofin[d0][4 * r4], ofin[d0][4 * r4 + 1]) | ((unsigned long long)cvtpk(ofin[d0][4 * r4 + 2], ofin[d0][4 * r4 + 3]) << 32); }
}
#undef PK8
}
__device__ __forceinline__ void attn_phase2(Frame& F, const KArgs& a) {
    { const int gt = F.vcu * (NWAVES * 64) + F.tid, NGT = F.G * NWAVES * 64; bf16* A2 = (bf16*)(a.ws + WS_A2);
      for (int i = gt; i < (M - MR) * (D / 8); i += NGT) *(GAS v4u*)(A2 + (size_t)MR * D + (size_t)i * 8) = (v4u){0u, 0u, 0u, 0u}; }
#ifndef REPS
#define REPS 1
#endif
#ifndef REPP
#define REPP 1
#endif
    for (int rep = 0; rep < REPS; ++rep)
    for (int task = F.vcu; task < SB * NKV * SS; task += F.G) { const int n = task >> 3, g = (task >> 2) & 1, s = task & 3; sattn::task(F, a, n, g, s); }
    for (int rep = 0; rep < REPP; ++rep)
    if (F.G == 256) { const int ng = F.vcu >> 3, s = F.vcu & 7;
#pragma unroll 1
        for (int i = 0; i < 4; ++i) { const int c = (i == 0) ? s : (i == 1) ? 15 - s : (i == 2) ? 16 + s : 31 - s; pattn::unit(F, a, ng >> 1, ng & 1, c); } }
    else { for (int u = F.vcu; u < NB * NKV * NBP; u += F.G) pattn::unit(F, a, u >> 6, (u >> 5) & 1, u & 31); }
}
namespace sk {
typedef short bf16x8v __attribute__((ext_vector_type(8)));
template <int NSTEP> __device__ __forceinline__ void kloop(const bf16* ap, const bf16* b0p, const bf16* b1p, f32x4& acc0, f32x4& acc1) {
#pragma unroll 4
    for (int s = 0; s < NSTEP; ++s) { const bf16x8v a = *(const GAS bf16x8v*)(ap + 32 * s), b0 = *(const GAS bf16x8v*)(b0p + 32 * s), b1 = *(const GAS bf16x8v*)(b1p + 32 * s);
        acc0 = __builtin_amdgcn_mfma_f32_16x16x32_bf16(a, b0, acc0, 0, 0, 0); acc1 = __builtin_amdgcn_mfma_f32_16x16x32_bf16(a, b1, acc1, 0, 0, 0); }
}
template <int K, class Epi> __device__ __forceinline__ void run1(Frame& F, const bf16* A, const bf16* Bt, int nN, const Epi& E) {
    const int lane = F.lane, r = lane & 15, kq = lane >> 4; const int gw = F.vcu * NWAVES + F.wave, NGW = F.G * NWAVES;
    for (int it = gw; it < 64 * nN; it += NGW) { const int mt = it & 7, q = (it >> 3) & 7, pn = it >> 6;
        f32x4 acc0 = {0.f, 0.f, 0.f, 0.f}, acc1 = {0.f, 0.f, 0.f, 0.f};
        kloop<K / 32>(A + (size_t)(16 * mt + r) * K + 8 * kq, Bt + (size_t)(256 * pn + 16 * q + r) * K + 8 * kq, Bt + (size_t)(256 * pn + 128 + 16 * q + r) * K + 8 * kq, acc0, acc1);
        E(mt, pn, q, lane, acc0, acc1); }
}
template <int K, class Epi> __device__ __forceinline__ void run8(Frame& F, const bf16* A, const bf16* Bt, int nN, const Epi& E) {
    const int lane = F.lane, r = lane & 15, kq = lane >> 4, w = F.wave; LAS f32x4* red = (LAS f32x4*)(F.lds);
    static_assert((K / 8) % 32 == 0, "K split");
    for (int it = F.vcu; it < 64 * nN; it += F.G) { const int mt = it & 7, q = (it >> 3) & 7, pn = it >> 6;
        f32x4 acc0 = {0.f, 0.f, 0.f, 0.f}, acc1 = {0.f, 0.f, 0.f, 0.f};
        const int kb = w * (K / 8);
        kloop<K / 8 / 32>(A + (size_t)(16 * mt + r) * K + kb + 8 * kq, Bt + (size_t)(256 * pn + 16 * q + r) * K + kb + 8 * kq, Bt + (size_t)(256 * pn + 128 + 16 * q + r) * K + kb + 8 * kq, acc0, acc1);
        __syncthreads();
        red[(w * 2 + 0) * 64 + lane] = acc0; red[(w * 2 + 1) * 64 + lane] = acc1;
        __syncthreads();
        if (w == 0) {
#pragma unroll
            for (int ww = 1; ww < 8; ++ww) { acc0 += red[(ww * 2 + 0) * 64 + lane]; acc1 += red[(ww * 2 + 1) * 64 + lane]; }
            E(mt, pn, q, lane, acc0, acc1); }
    }
    __syncthreads();
}
struct SwiGLU { bf16* H;
    __device__ __forceinline__ void operator()(int mt, int pn, int q, int lane, const f32x4& a0, const f32x4& a1) const {
#pragma unroll
        for (int i = 0; i < 4; ++i) { const int r = 16 * mt + (lane >> 4) * 4 + i; H[(size_t)(MP + r) * FF + 128 * pn + 16 * q + (lane & 15)] = (bf16)f2bf(pg8::silu_mul(a0[i], a1[i])); } } };
struct ResPre { const float* base_s; float* V; float alpha, s;
    __device__ __forceinline__ void operator()(int mt, int pn, int q, int lane, const f32x4& a0, const f32x4& a1) const {
#pragma unroll
        for (int i = 0; i < 4; ++i) { const int r = 16 * mt + (lane >> 4) * 4 + i; const int c = 256 * pn + 16 * q + (lane & 15);
            V[(size_t)(MP + r) * D + c] = alpha * base_s[(size_t)r * D + c] + s * a0[i]; V[(size_t)(MP + r) * D + c + 128] = alpha * base_s[(size_t)r * D + c + 128] + s * a1[i]; } } };
struct InProj { const float* biasp; bf16* CB; float* U; bf16* Q; bf16* KS; bf16* KW; float* G; float* out;
    __device__ __forceinline__ void operator()(int mt, int pn, int q, int lane, const f32x4& a0, const f32x4& a1) const {
        const int c = 16 * q + (lane & 15); const float b0 = biasp[256 * pn + c], b1 = biasp[256 * pn + 128 + c];
#pragma unroll
        for (int i = 0; i < 4; ++i) { const int si = 16 * mt + (lane >> 4) * 4 + i, r = MP + si, n = si >> 2, s = si & 3; const float v0 = a0[i] + b0, v1 = a1[i] + b1;
            if (pn < 2) { CB[(size_t)r * DC + 256 * pn + c] = (bf16)f2bf(v0); CB[(size_t)r * DC + 256 * pn + 128 + c] = (bf16)f2bf(v1); }
            else if (pn < 6) { const int ch = 128 * (pn - 2) + c; const float u = v0 * v1; U[(size_t)r * DC + ch] = u; if (s >= 2) out[O_SCONV + (size_t)(n * 2 + (s - 2)) * DC + ch] = u; }
            else if (pn < 8) { Q[(size_t)r * DA + 256 * (pn - 6) + c] = (bf16)f2bf(v0 * QSCALE); Q[(size_t)r * DA + 256 * (pn - 6) + 128 + c] = (bf16)f2bf(v1 * QSCALE); }
            else if (pn == 8) { out[O_SCMP + (size_t)si * KVW + c] = v0; out[O_SCMP + (size_t)si * KVW + 128 + c] = v1; }
            else if (pn == 9) { out[O_SSEL + (size_t)si * KVW + c] = v0; out[O_SSEL + (size_t)si * KVW + 128 + c] = v1; KS[(size_t)r * KVW + c] = (bf16)f2bf(v0); KS[(size_t)r * KVW + 128 + c] = (bf16)f2bf(v1); }
            else if (pn == 10) { float* o = out + O_SWIN + (size_t)(n * WIN + (WIN - SS) + s) * KVW; o[c] = v0; o[128 + c] = v1; KW[(size_t)r * KVW + c] = (bf16)f2bf(v0); KW[(size_t)r * KVW + 128 + c] = (bf16)f2bf(v1); }
            else { if (c < 24) G[(size_t)r * 32 + c] = __builtin_amdgcn_rcpf(1.0f + __builtin_amdgcn_exp2f(-1.4426950408889634f * v0)); }
        } } };
}
#ifndef REP0
#define REP0 1
#endif
#ifndef REP3
#define REP3 1
#endif
#ifndef REP5
#define REP5 1
#endif
#ifndef REP6
#define REP6 1
#endif
#ifndef ATTN_PLACEHOLDER
#define ATTN_PLACEHOLDER 0
#endif
__global__ void __launch_bounds__(NWAVES * 64, 2) mk_fwd(KArgs args) {
    extern __shared__ __attribute__((aligned(16))) unsigned char lds[];
    Frame F;
    F.lds = (LAS unsigned char*)lds;
    F.MISC = (volatile LAS unsigned*)(F.lds + MISC_OFF);
    F.tid = threadIdx.x; F.lane = F.tid & 63; F.wave = __builtin_amdgcn_readfirstlane(F.tid >> 6);
    F.G = gridDim.x; { const int bx = blockIdx.x; F.vcu = (F.G % 8 == 0) ? (bx % 8) * (F.G / 8) + bx / 8 : bx; }
    unsigned char* ws = args.ws;
    F.ctl = (gu32*)(ws + WS_CTL);
    for (int u = F.tid; u < (LDS_BYTES - LDSCTL_OFF) / 4; u += NWAVES * 64) ((LAS unsigned*)(F.lds + LDSCTL_OFF))[u] = 0u;
    __syncthreads();
    XcdBarrier bar = xcd_barrier_post((unsigned*)(F.ctl + CW_BAR), F.MISC + 8);
    const int lo = args.ph_lo, hi = args.ph_hi;
#define IN(k) (lo <= (k) && (k) < hi)
#define GRID_BAR() xcd_barrier(bar)
    bf16* XB = (bf16*)(ws + WS_XB); bf16* HB = (bf16*)(ws + WS_H); float* V = (float*)(ws + WS_V); float* X1 = (float*)(ws + WS_X1); float* X2 = (float*)(ws + WS_X2);
    bf16* A2 = (bf16*)(ws + WS_A2);
    float* out = args.out;

    if (IN(0)) { for (int rep = 0; rep < REP0; ++rep) p0_prologue(F, args); GRID_BAR(); }
    if (IN(1)) { sk::run1<D>(F, XB + (size_t)MP * D, (const bf16*)(ws + WS_WGUA), NGU / 256, sk::SwiGLU{HB});
        pg8::Gemm g{XB, (const bf16*)(ws + WS_WGUA), MP, NGU, D}; pg8::StaticOrder S; S.init(MP, NGU, F.G, (int)blockIdx.x);
        pg8::EpiSwiGLU E{HB}; pg8::gemm_phase<pg8::EpiSwiGLU, pg8::StaticOrder, true, true>(F.lds + RING_OFF, g, S, E); GRID_BAR(); }
    if (IN(2)) { sk::run8<FF>(F, HB + (size_t)MP * FF, (const bf16*)(ws + WS_WDA), D / 256, sk::ResPre{(const float*)args.in[1], V, ALPHA, 0.5f});
        pg8::Gemm g{HB, (const bf16*)(ws + WS_WDA), MP, D, FF}; pg8::StaticOrder S; S.init(MP, D, F.G, (int)blockIdx.x);
        pg8::EpiResPre E{(const float*)args.in[0], (const float*)args.in[1], V, ALPHA, 0.5f}; pg8::gemm_phase<pg8::EpiResPre, pg8::StaticOrder, true, true>(F.lds + RING_OFF, g, S, E); GRID_BAR(); }
    if (IN(3)) { for (int rep = 0; rep < REP3; ++rep) ln_phase(F, V, (const float*)args.in[10], (const float*)args.in[11], X1, X1 + (size_t)MP * D, XB); GRID_BAR(); }
    if (IN(4)) { sk::run1<D>(F, XB + (size_t)MP * D, (const bf16*)(ws + WS_WIN), NINP / 256,
                             sk::InProj{(const float*)(ws + WS_BIASP), (bf16*)(ws + WS_CB), (float*)(ws + WS_U), (bf16*)(ws + WS_Q), (bf16*)(ws + WS_KS), (bf16*)(ws + WS_KW), (float*)(ws + WS_G), out});
        pg8::Gemm g{XB, (const bf16*)(ws + WS_WIN), MP, NINP, D}; pg8::StaticOrder S; S.init(MP, NINP, F.G, (int)blockIdx.x);
        pg8::EpiInProj E{(const float*)(ws + WS_BIASP), (bf16*)(ws + WS_CB), (float*)(ws + WS_U), (bf16*)(ws + WS_Q), (bf16*)(ws + WS_KS), (bf16*)(ws + WS_KW), (float*)(ws + WS_G), out};
        pg8::gemm_phase<pg8::EpiInProj, pg8::StaticOrder, true, true>(F.lds + RING_OFF, g, S, E); GRID_BAR(); }
    if (IN(5)) { for (int rep = 0; rep < REP5; ++rep) {
        conv_phase(F, args);
#if !ATTN_PLACEHOLDER
#ifndef NO_COMPRESS
        compress_phase(F, args);
#endif
#endif
        }
        GRID_BAR(); }
    if (IN(6)) { for (int rep = 0; rep < REP6; ++rep) {
#if ATTN_PLACEHOLDER
        { const int gt = F.vcu * (NWAVES * 64) + F.tid, NGT = F.G * NWAVES * 64;
          for (int i = gt; i < M * (DA / 8); i += NGT) { const int m = i / (DA / 8), c = i % (DA / 8); *(GAS v4u*)(A2 + (size_t)m * D + c * 8) = (v4u){0u, 0u, 0u, 0u}; }
          for (int i = gt; i < (M - MR) * (DC / 8); i += NGT) { const int m = MR + i / (DC / 8), c = i % (DC / 8); *(GAS v4u*)(A2 + (size_t)m * D + DA + c * 8) = (v4u){0u, 0u, 0u, 0u}; } }
#else
#ifndef NO_ATTN
        attn_phase2(F, args);
#endif
#endif
        }
        GRID_BAR(); }
    if (IN(7)) { sk::run8<D>(F, A2 + (size_t)MP * D, (const bf16*)(ws + WS_WOUT), D / 256, sk::ResPre{X1 + (size_t)MP * D, V, ALPHA, 1.0f});
        pg8::Gemm g{A2, (const bf16*)(ws + WS_WOUT), MP, D, D}; pg8::StaticOrder S; S.init(MP, D, F.G, (int)blockIdx.x);
        pg8::EpiResPre E{X1, X1 + (size_t)MP * D, V, ALPHA, 1.0f}; pg8::gemm_phase<pg8::EpiResPre, pg8::StaticOrder, true, true>(F.lds + RING_OFF, g, S, E); GRID_BAR(); }
    if (IN(8)) { ln_phase(F, V, (const float*)args.in[19], (const float*)args.in[20], X2, X2 + (size_t)MP * D, XB); GRID_BAR(); }
    if (IN(9)) { sk::run1<D>(F, XB + (size_t)MP * D, (const bf16*)(ws + WS_WGUB), NGU / 256, sk::SwiGLU{HB});
        pg8::Gemm g{XB, (const bf16*)(ws + WS_WGUB), MP, NGU, D}; pg8::StaticOrder S; S.init(MP, NGU, F.G, (int)blockIdx.x);
        pg8::EpiSwiGLU E{HB}; pg8::gemm_phase<pg8::EpiSwiGLU, pg8::StaticOrder, true, true>(F.lds + RING_OFF, g, S, E); GRID_BAR(); }
    if (IN(10)) { sk::run8<FF>(F, HB + (size_t)MP * FF, (const bf16*)(ws + WS_WDB), D / 256, sk::ResPre{X2 + (size_t)MP * D, V, ALPHA, 0.5f});
        pg8::Gemm g{HB, (const bf16*)(ws + WS_WDB), MP, D, FF}; pg8::StaticOrder S; S.init(MP, D, F.G, (int)blockIdx.x);
        pg8::EpiResPre E{X2, X2 + (size_t)MP * D, V, ALPHA, 0.5f}; pg8::gemm_phase<pg8::EpiResPre, pg8::StaticOrder, true, true>(F.lds + RING_OFF, g, S, E); GRID_BAR(); }
    if (IN(11)) { ln_phase(F, V, (const float*)args.in[24], (const float*)args.in[25], out + O_YP, out + O_YS, nullptr); }
#undef IN
#undef GRID_BAR
}

extern "C" void kernel_launch(void* const* d_in, const int* in_sizes, int n_in, void* d_out, int out_size, void* d_ws, size_t ws_size, hipStream_t stream) {
    static int grid = 0;
    if (grid == 0) {
        if (n_in != 26 || (size_t)out_size != O_END || ws_size < WS_END) { fprintf(stderr, "kernel_launch: unexpected shapes (n_in %d out %d ws %zu)\n", n_in, out_size, ws_size); grid = -1; return; }
        int dev = 0, cus = 0, per_cu = 0;
        if (hipGetDevice(&dev) != hipSuccess || hipDeviceGetAttribute(&cus, hipDeviceAttributeMultiprocessorCount, dev) != hipSuccess) { grid = -1; return; }
        if (hipFuncSetAttribute((const void*)mk_fwd, hipFuncAttributeMaxDynamicSharedMemorySize, LDS_BYTES) != hipSuccess) { fprintf(stderr, "kernel_launch: hipFuncSetAttribute failed\n"); grid = -1; return; }
        if (hipOccupancyMaxActiveBlocksPerMultiprocessor(&per_cu, (const void*)mk_fwd, NWAVES * 64, LDS_BYTES) != hipSuccess || per_cu < 1)
            fprintf(stderr, "kernel_launch: occupancy query reports %d workgroups per CU\n", per_cu);
        (void)hipGetLastError();
        grid = cus;
    }
    if (grid < 0) return;
    if (hipMemsetAsync((char*)d_ws + WS_CTL, 0, CTL_ZERO_BYTES, stream) != hipSuccess) return;
    KArgs a{};
    for (int i = 0; i < 26; ++i) a.in[i] = d_in[i];
    a.out = (float*)d_out; a.ws = (unsigned char*)d_ws; a.ph_lo = 0; a.ph_hi = 12;
    hipLaunchKernelGGL(mk_fwd, dim3(grid), dim3(NWAVES * 64), LDS_BYTES, stream, a);
}
```
